# Optimizing an MI355X kernel written in HIP

```python
import jax
import jax.numpy as jnp
from jax import lax
import numpy as np

D_MODEL = 1024
BATCH = 4
SEQ = 8192
DEPTH = 2

GRID_W = 64
CTX_LEN = 256
EPS = 1e-6
N_MOD = 6
HEAD_DIM = 64
N_Q_HEADS = D_MODEL // 128
N_KV_HEADS = N_Q_HEADS // 4
Q_GROUP = N_Q_HEADS // N_KV_HEADS
Q_W = N_Q_HEADS * HEAD_DIM
KV_W = N_KV_HEADS * HEAD_DIM
Q_BLOCK = 128
ROPE_THETA = 10000.0
ROPE_AXIS_DIM = HEAD_DIM // 2
ROPE_FREQS = ROPE_AXIS_DIM // 2
GMLP_CHUNK = 128
GMLP_GROUPS = 4
GMLP_WIDTH = D_MODEL // 2
GMLP_GROUP_W = GMLP_WIDTH // GMLP_GROUPS
GLA_HEADS = 4
GLA_QK_W = D_MODEL // 4
GLA_V_W = D_MODEL // 2
GLA_DK = GLA_QK_W // GLA_HEADS
GLA_DV = GLA_V_W // GLA_HEADS
GLA_RANK = 16
GLA_TAU = 16.0
GLA_CHUNK = 64
FFN_HIDDEN = 128 * ((8 * D_MODEL // 3 + 127) // 128)
CONV_WIDTH = 3
IN_SPLITS = (GMLP_WIDTH, GMLP_WIDTH, Q_W, KV_W, KV_W, GLA_QK_W, GLA_QK_W, GLA_V_W, GLA_RANK, GLA_RANK, GLA_V_W, D_MODEL, D_MODEL, D_MODEL)
IN_WIDTH = sum(IN_SPLITS)

kernel_name = "hybrid_gated_branch_diffusion_block"


def rms_norm(x, g):
    xf = x.astype(jnp.float32)
    y = xf * lax.rsqrt(jnp.mean(xf * xf, axis=-1, keepdims=True) + EPS)
    return (y * g.astype(jnp.float32)).astype(x.dtype)


def adaln(cond, w, b):
    m = jax.nn.silu(cond) @ w + b
    return m.reshape(cond.shape[0], 1, N_MOD, D_MODEL)


def modulate(h, shift, scale):
    return h * (1 + scale) + shift


def split_in(p):
    out, start = [], 0
    for w in IN_SPLITS:
        out.append(p[..., start:start + w])
        start += w
    return out


def to_heads(p, n_heads, dim):
    return p.reshape(p.shape[0], p.shape[1], n_heads, dim)


def axial_rope_tables(n_tokens, dtype):
    rows = n_tokens // GRID_W
    t_row = jnp.repeat(jnp.arange(rows, dtype=jnp.int32), GRID_W)
    t_col = jnp.tile(jnp.arange(GRID_W, dtype=jnp.int32), rows)
    inv_freq = ROPE_THETA ** (-jnp.arange(ROPE_FREQS, dtype=jnp.float32) / ROPE_FREQS)
    ang_r = t_row.astype(jnp.float32)[:, None] * inv_freq
    ang_c = t_col.astype(jnp.float32)[:, None] * inv_freq
    return (jnp.cos(ang_r).astype(dtype)[:, None, :], jnp.sin(ang_r).astype(dtype)[:, None, :],
            jnp.cos(ang_c).astype(dtype)[:, None, :], jnp.sin(ang_c).astype(dtype)[:, None, :])


def rope_half(x, cos, sin):
    x1, x2 = x[..., :ROPE_FREQS], x[..., ROPE_FREQS:]
    return jnp.concatenate([x1 * cos - x2 * sin, x1 * sin + x2 * cos], axis=-1)


def apply_axial_rope(x, tables):
    cr, sr, cc, sc = tables
    return jnp.concatenate([rope_half(x[..., :ROPE_AXIS_DIM], cr, sr),
                            rope_half(x[..., ROPE_AXIS_DIM:], cc, sc)], axis=-1)


def block_attention(q, k, v):
    b, t = q.shape[0], q.shape[1]
    nb = t // Q_BLOCK
    qb = q.reshape(b, nb, Q_BLOCK, N_KV_HEADS, Q_GROUP, HEAD_DIM).transpose(1, 0, 2, 3, 4, 5)
    scale = HEAD_DIM ** -0.5

    def one_block(qi):
        s = jnp.einsum('bqhgd,bkhd->bhgqk', qi, k).astype(jnp.float32) * scale
        p = jax.nn.softmax(s, axis=-1).astype(v.dtype)
        return jnp.einsum('bhgqk,bkhd->bqhgd', p, v)

    o = lax.map(one_block, qb)
    return o.transpose(1, 0, 2, 3, 4, 5).reshape(b, t, Q_W)


def chunk_gmlp(u, v, norm_g, w_s, b_s):
    b, t, _ = u.shape
    n = t // GMLP_CHUNK
    u = jax.nn.gelu(u)
    v = rms_norm(jax.nn.gelu(v).reshape(b, n, GMLP_CHUNK, GMLP_GROUPS, GMLP_GROUP_W),
                 norm_g.reshape(GMLP_GROUPS, GMLP_GROUP_W))
    f = jnp.einsum('gij,bnjgc->bnigc', w_s, v) + b_s.T[:, :, None]
    return u * f.reshape(b, t, GMLP_WIDTH)


def gla_inputs(p_q, p_k, p_v, p_af, p_ab, w_a2, b_a):
    b, t, _ = p_q.shape
    q = to_heads(p_q, GLA_HEADS, GLA_DK) * (GLA_DK ** -0.5)
    k = to_heads(p_k, GLA_HEADS, GLA_DK)
    v = to_heads(p_v, GLA_HEADS, GLA_DV)

    def log_decay(a1, w2, b2):
        z = (a1 @ w2 + b2).astype(jnp.float32)
        return (jax.nn.log_sigmoid(z) / GLA_TAU).reshape(b, t, GLA_HEADS, GLA_DK)

    return q, k, v, log_decay(p_af, w_a2[0], b_a[0]), log_decay(p_ab, w_a2[1], b_a[1])


def gla_chunked(q, k, v, log_a, s0):
    b, t, h, dk = q.shape
    dv = v.shape[-1]
    n = t // GLA_CHUNK
    q = q.astype(jnp.float32).reshape(b, n, GLA_CHUNK, h, dk)
    k = k.astype(jnp.float32).reshape(b, n, GLA_CHUNK, h, dk)
    v = v.astype(jnp.float32).reshape(b, n, GLA_CHUNK, h, dv)
    cum = jnp.cumsum(log_a.astype(jnp.float32).reshape(b, n, GLA_CHUNK, h, dk), axis=2)
    cum_last = cum[:, :, -1:]
    q_in = q * jnp.exp(cum)
    k_in = k * jnp.exp(-cum)
    k_st = k * jnp.exp(cum_last - cum)
    mask = jnp.tril(jnp.ones((GLA_CHUNK, GLA_CHUNK), dtype=bool))
    att = jnp.where(mask, jnp.einsum('bnihd,bnjhd->bnhij', q_in, k_in), 0.0)
    o = jnp.einsum('bnhij,bnjhv->bnihv', att, v)
    u = jnp.einsum('bnjhd,bnjhv->nbhdv', k_st, v)
    decay = jnp.exp(cum_last[:, :, 0]).transpose(1, 0, 2, 3)

    def step(s, inp):
        d, u_n = inp
        return d[..., None] * s + u_n, s

    s_final, s_in = lax.scan(step, s0.astype(jnp.float32), (decay, u))
    o = o + jnp.einsum('bnihd,nbhdv->bnihv', q_in, s_in)
    return o.reshape(b, t, h, dv), s_final


def gla_chunked_reverse(q, k, v, log_a, s0):
    o, s = gla_chunked(q[:, ::-1], k[:, ::-1], v[:, ::-1], log_a[:, ::-1], s0)
    return o[:, ::-1], s


def gla_output(o, r, g):
    b, t = o.shape[0], o.shape[1]
    o = rms_norm(o, g.reshape(GLA_HEADS, GLA_DV)).reshape(b, t, GLA_V_W)
    return (o * jax.nn.silu(r.astype(jnp.float32))).astype(r.dtype)


def merge_branches(gate_logits, y_a, y_b, y_c, w_a, w_b, w_c, w_o):
    g_a, g_b, g_c = gate_logits
    merged = (jax.nn.sigmoid(g_a) * (y_a @ w_a) + jax.nn.sigmoid(g_b) * (y_b @ w_b)
              + jax.nn.sigmoid(g_c) * (y_c @ w_c))
    return merged @ w_o


def conv_ffn(h, w_up, cw, cb, w_down):
    t = h.shape[1]
    half = CONV_WIDTH // 2
    a = h @ w_up
    ap = jnp.pad(a, ((0, 0), (half, half), (0, 0)))
    a = cb + sum(ap[:, j:j + t] * cw[j] for j in range(CONV_WIDTH))
    g, val = jnp.split(a, 2, axis=-1)
    return (jax.nn.silu(g) * val) @ w_down


def setup_inputs(seed: int = 0) -> dict:
    key = jax.random.key(seed)
    ks = jax.random.split(key, 26)
    f32 = jnp.float32
    nrm = lambda k, shape, scale: jax.random.normal(k, shape, f32) * scale
    gain = lambda k, shape: 1.0 + 0.02 * jax.random.normal(k, shape, f32)
    F2 = 2 * FFN_HIDDEN
    return {
        'x': nrm(ks[0], (BATCH, SEQ, D_MODEL), 1.0),
        'c': nrm(ks[1], (BATCH, D_MODEL), 1.0),
        'ctx': nrm(ks[2], (BATCH, CTX_LEN, D_MODEL), 1.0),
        'c_ctx': nrm(ks[3], (D_MODEL,), 1.0),
        'w_ada': nrm(ks[4], (DEPTH, D_MODEL, N_MOD * D_MODEL), 0.5 * D_MODEL ** -0.5),
        'b_ada': nrm(ks[5], (DEPTH, N_MOD * D_MODEL), 0.02),
        'norm1_g': gain(ks[6], (DEPTH, D_MODEL)),
        'norm2_g': gain(ks[7], (DEPTH, D_MODEL)),
        'w_in': nrm(ks[8], (DEPTH, D_MODEL, IN_WIDTH), D_MODEL ** -0.5),
        'q_norm_g': gain(ks[9], (DEPTH, HEAD_DIM)),
        'k_norm_g': gain(ks[10], (DEPTH, HEAD_DIM)),
        'gmlp_norm_g': gain(ks[11], (DEPTH, GMLP_WIDTH)),
        'w_spatial': nrm(ks[12], (DEPTH, GMLP_GROUPS, GMLP_CHUNK, GMLP_CHUNK), 0.5 * GMLP_CHUNK ** -0.5),
        'b_spatial': gain(ks[13], (DEPTH, GMLP_GROUPS, GMLP_CHUNK)),
        'w_alpha2': nrm(ks[14], (DEPTH, 2, GLA_RANK, GLA_QK_W), GLA_RANK ** -0.5),
        'b_alpha': nrm(ks[15], (DEPTH, 2, GLA_QK_W), 0.02),
        'gla_norm_g': gain(ks[16], (DEPTH, GLA_V_W)),
        'w_br_a': nrm(ks[17], (DEPTH, GMLP_WIDTH, D_MODEL), GMLP_WIDTH ** -0.5),
        'w_br_b': nrm(ks[18], (DEPTH, Q_W, D_MODEL), Q_W ** -0.5),
        'w_br_c': nrm(ks[19], (DEPTH, GLA_V_W, D_MODEL), GLA_V_W ** -0.5),
        'w_out': nrm(ks[20], (DEPTH, D_MODEL, D_MODEL), D_MODEL ** -0.5),
        'w_ffn_up': nrm(ks[21], (DEPTH, D_MODEL, F2), D_MODEL ** -0.5),
        'conv_w': nrm(ks[22], (DEPTH, CONV_WIDTH, F2), CONV_WIDTH ** -0.5),
        'conv_b': nrm(ks[23], (DEPTH, F2), 0.02),
        'w_ffn_down': nrm(ks[24], (DEPTH, FFN_HIDDEN, D_MODEL), FFN_HIDDEN ** -0.5),
        'final_norm_g': gain(ks[25], (D_MODEL,)),
    }


def reference(x, c, ctx, c_ctx, w_ada, b_ada, norm1_g, norm2_g, w_in, q_norm_g, k_norm_g,
              gmlp_norm_g, w_spatial, b_spatial, w_alpha2, b_alpha, gla_norm_g, w_br_a, w_br_b,
              w_br_c, w_out, w_ffn_up, conv_w, conv_b, w_ffn_down, final_norm_g):
    rope_tab = axial_rope_tables(x.shape[1], x.dtype)
    xc = ctx
    for l in range(DEPTH):
        last = l == DEPTH - 1
        mod_x = adaln(c, w_ada[l], b_ada[l])
        mod_c = adaln(c_ctx[None], w_ada[l], b_ada[l])
        hx = modulate(rms_norm(x, norm1_g[l]), mod_x[:, :, 0], mod_x[:, :, 1])
        hc = modulate(rms_norm(xc, norm1_g[l]), mod_c[:, :, 0], mod_c[:, :, 1])
        px = split_in(hx @ w_in[l])
        pc = split_in(hc @ w_in[l])

        kc = rms_norm(to_heads(pc[3], N_KV_HEADS, HEAD_DIM), k_norm_g[l])
        vc = to_heads(pc[4], N_KV_HEADS, HEAD_DIM)
        qx = apply_axial_rope(rms_norm(to_heads(px[2], N_Q_HEADS, HEAD_DIM), q_norm_g[l]), rope_tab)
        kx = apply_axial_rope(rms_norm(to_heads(px[3], N_KV_HEADS, HEAD_DIM), k_norm_g[l]), rope_tab)
        vx = to_heads(px[4], N_KV_HEADS, HEAD_DIM)
        att_x = block_attention(qx, jnp.concatenate([kc, kx], axis=1), jnp.concatenate([vc, vx], axis=1))

        qgc, kgc, vgc, lfc, lbc = gla_inputs(*pc[5:10], w_alpha2[l], b_alpha[l])
        s0 = jnp.zeros((xc.shape[0], GLA_HEADS, GLA_DK, GLA_DV), jnp.float32)
        oc_f, sc_f = gla_chunked(qgc, kgc, vgc, lfc, s0)
        oc_b, sc_b = gla_chunked_reverse(qgc, kgc, vgc, lbc, s0)
        qgx, kgx, vgx, lfx, lbx = gla_inputs(*px[5:10], w_alpha2[l], b_alpha[l])
        ox_f, _ = gla_chunked(qgx, kgx, vgx, lfx, sc_f)
        ox_b, _ = gla_chunked_reverse(qgx, kgx, vgx, lbx, sc_b)
        gla_x = gla_output(ox_f + ox_b, px[10], gla_norm_g[l])

        gm_x = chunk_gmlp(px[0], px[1], gmlp_norm_g[l], w_spatial[l], b_spatial[l])

        mix_x = merge_branches(px[11:14], gm_x, att_x, gla_x, w_br_a[l], w_br_b[l], w_br_c[l], w_out[l])
        x_mid = x + mod_x[:, :, 2] * mix_x
        hx2 = modulate(rms_norm(x_mid, norm2_g[l]), mod_x[:, :, 3], mod_x[:, :, 4])
        x = x_mid + mod_x[:, :, 5] * conv_ffn(hx2, w_ffn_up[l], conv_w[l], conv_b[l], w_ffn_down[l])

        if not last:
            qc = rms_norm(to_heads(pc[2], N_Q_HEADS, HEAD_DIM), q_norm_g[l])
            att_c = block_attention(qc, kc, vc)
            gla_c = gla_output(oc_f + oc_b, pc[10], gla_norm_g[l])
            gm_c = chunk_gmlp(pc[0], pc[1], gmlp_norm_g[l], w_spatial[l], b_spatial[l])
            mix_c = merge_branches(pc[11:14], gm_c, att_c, gla_c, w_br_a[l], w_br_b[l], w_br_c[l], w_out[l])
            xc_mid = xc + mod_c[:, :, 2] * mix_c
            hc2 = modulate(rms_norm(xc_mid, norm2_g[l]), mod_c[:, :, 3], mod_c[:, :, 4])
            xc = xc_mid + mod_c[:, :, 5] * conv_ffn(hc2, w_ffn_up[l], conv_w[l], conv_b[l], w_ffn_down[l])
    return rms_norm(x, final_norm_g)
```

```cpp
#include <hip/hip_runtime.h>
#include <hip/hip_cooperative_groups.h>
#include <cstdio>
#include <cstdint>
namespace cg = cooperative_groups;
namespace pg8 {
#define PG8_LAS __attribute__((address_space(3)))
typedef unsigned short bf16_t;
typedef short bf16x8 __attribute__((ext_vector_type(8)));
typedef float f32x4 __attribute__((ext_vector_type(4)));
typedef unsigned u32x4 __attribute__((ext_vector_type(4)));
constexpr int BM = 256, BK = 64, HALF = 128, HTB = HALF * BK * 2  , STAGE_BYTES = 8 * HTB, NXCD = 8, WGM = 8;

__host__ __device__ __forceinline__ int lds_byte(int r, int c) { const int st = (r >> 4) * 2 + (c >> 5), rr = r & 15, cc = c & 31, ob = rr * 64 + cc * 2; return st * 1024 + (ob ^ (((ob >> 9) & 1) << 5)); }
__host__ __device__ __forceinline__ void stage_rc(int b, int& R, int& C) { const int st = b / 1024, sb = b % 1024, swz = sb ^ (((sb >> 9) & 1) << 5); R = (st >> 1) * 16 + swz / 64; C = (st & 1) * 32 + (swz % 64) / 2; }
__host__ __device__ __forceinline__ int perm32(int rho) { const int n = rho >> 4, i = rho & 15; return 8 * (i >> 2) + 4 * n + (i & 3); }

struct Unit { int pm, pn; };
struct Gemm { const bf16_t* A; const bf16_t* Bt; int M, N, K, lda; };

struct StaticOrder {
    int nM, nN, nwg, G, c;
    __host__ __device__ void init(int M, int N, int G_, int c_) { nM = M / BM; nN = N / BM; nwg = nM * nN; G = G_; c = c_; }
    __host__ __device__ bool next(int i, Unit& u) const {
        const long L = (long)i * G + c; if (L >= nwg) return false;
        int wgid = (int)L; { const int q = nwg / NXCD, r = nwg % NXCD, xcd = wgid % NXCD, off = wgid / NXCD; wgid = (xcd < r ? xcd * (q + 1) : r * (q + 1) + (xcd - r) * q) + off; }
        const int nig = WGM * nN, gid = wgid / nig, fm = gid * WGM, gsz = (nM - fm) < WGM ? (nM - fm) : WGM;
        u.pm = fm + ((wgid % nig) % gsz); u.pn = (wgid % nig) / gsz; return true;
    }
    __device__ __forceinline__ void a_ready(const Unit&) const {}
    __device__ __forceinline__ void done(const Unit&) const {}
};

__device__ __forceinline__ unsigned cvt_pk_bf16(float lo, float hi) { unsigned r; asm volatile("v_cvt_pk_bf16_f32 %0, %1, %2" : "=v"(r) : "v"(lo), "v"(hi)); return r; }
typedef float f32x2 __attribute__((ext_vector_type(2)));
__device__ __forceinline__ f32x2 gelu_pk(f32x2 v) {
    const f32x2 av = __builtin_elementwise_abs(v), d = av * 0.2316418882f + 1.0f;
    f32x2 t; t.x = __builtin_amdgcn_rcpf(d.x); t.y = __builtin_amdgcn_rcpf(d.y);
    f32x2 q = t * 0.5307027145f + (-0.7265760135f); q = q * t + 0.7107068705f; q = q * t + (-0.142248368f); q = q * t + 0.127414796f; q = q * t;
    const f32x2 s = (v * v) * (-0.72134752044f);
    f32x2 e; e.x = __builtin_amdgcn_exp2f(s.x); e.y = __builtin_amdgcn_exp2f(s.y);
    const f32x2 m = v * (q * e), r = v - m;
    f32x2 o; o.x = v.x < 0.f ? m.x : r.x; o.y = v.y < 0.f ? m.y : r.y; return o;
}


template <class Epi, class Sched, bool ALIGN_EPI = false, bool SP2 = false>
__device__ __forceinline__ void gemm_phase(PG8_LAS unsigned char* lds, const Gemm g, const Sched& S, const Epi& E) {
    int tid = threadIdx.x; asm volatile("" : "+v"(tid)); const int wid = __builtin_amdgcn_readfirstlane(tid >> 6), lane = tid & 63, wr = wid >> 2, wc = wid & 3, fr = lane & 15, fq = lane >> 4;
    const int K = g.K, nt = K / BK;
    unsigned voffA[2], voffB[2];
#pragma unroll
    for (int i = 0; i < 2; ++i) { int R, C; stage_rc(tid * 16 + i * 8192, R, C); const int Rb = Epi::PERM ? ((R & ~31) + perm32(R & 31)) : R;
        voffA[i] = (unsigned)(R * g.lda + C) * 2u; voffB[i] = (unsigned)(Rb * K + C) * 2u; }
    const size_t kstep = (size_t)(BK * 2);
    const size_t hstepA = (size_t)HALF * g.lda * 2, hstepB = (size_t)HALF * K * 2;
    const size_t tstepA = 2 * hstepA, tstepB = 2 * hstepB;
    const unsigned ldsw = (unsigned)wid * 1024u;
    const int aoff = lds_byte(wr * 64 + fr, fq * 8), boff = lds_byte(wc * 32 + fr, fq * 8);
#define PG8_SA(b, h) (((b) * 2 + (h)) * HTB)
#define PG8_SB(b, h) ((4 + (b) * 2 + (h)) * HTB)
#define PG8_STAGE(bufoff, gbase, voff) do { _Pragma("unroll") for (int _i = 0; _i < 2; ++_i) \
        __builtin_amdgcn_global_load_lds((const unsigned*)((const char*)(gbase) + (voff)[_i]), (PG8_LAS unsigned*)(lds + (bufoff) + ldsw + _i * 8192), 16, 0, 0); } while (0)
#define PG8_LDA(dst, b, h) do { _Pragma("unroll") for (int m = 0; m < 4; ++m) _Pragma("unroll") for (int k = 0; k < 2; ++k) dst[m][k] = *(const PG8_LAS bf16x8*)(lds + PG8_SA(b, h) + aoff + m * 2048 + k * 1024); } while (0)
#define PG8_LDB(dst, b, h) do { _Pragma("unroll") for (int n = 0; n < 2; ++n) _Pragma("unroll") for (int k = 0; k < 2; ++k) dst[n][k] = *(const PG8_LAS bf16x8*)(lds + PG8_SB(b, h) + boff + n * 2048 + k * 1024); } while (0)
#define PG8_MMA(ai, bj, At, Bt) do { __builtin_amdgcn_s_setprio(1); _Pragma("unroll") for (int m = 0; m < 4; ++m) _Pragma("unroll") for (int n = 0; n < 2; ++n) _Pragma("unroll") for (int k = 0; k < 2; ++k) \
        acc[ai][bj][m][n] = __builtin_amdgcn_mfma_f32_16x16x32_bf16(Bt[n][k], At[m][k], acc[ai][bj][m][n], 0, 0, 0); __builtin_amdgcn_s_setprio(0); } while (0)
#define PG8_WAIT_V(n) asm volatile("s_waitcnt vmcnt(" #n ")" ::: "memory")
#define PG8_WAIT_L(n) asm volatile("s_waitcnt lgkmcnt(" #n ")" ::: "memory")
#define PG8_BAR __builtin_amdgcn_s_barrier()
#define PG8_SCHED __builtin_amdgcn_sched_barrier(0)
    Unit cur, nxt; int ui = 0;
    if (!S.next(0, cur)) return;
    f32x4 acc[2][2][4][2];
#pragma unroll
    for (int a = 0; a < 2; ++a)
#pragma unroll
        for (int b = 0; b < 2; ++b)
#pragma unroll
            for (int m = 0; m < 4; ++m)
#pragma unroll
                for (int n = 0; n < 2; ++n) acc[a][b][m][n] = (f32x4){0.f, 0.f, 0.f, 0.f};
    bf16x8 At[4][2], B0[2][2], B1[2][2];
    const char* cA = (const char*)g.A + (size_t)cur.pm * tstepA; const char* cB = (const char*)g.Bt + (size_t)cur.pn * tstepB;
    S.a_ready(cur);
    if constexpr (SP2) {
        PG8_STAGE(PG8_SB(0, 0), cB, voffB); PG8_STAGE(PG8_SB(0, 1), cB + hstepB, voffB); PG8_STAGE(PG8_SA(0, 0), cA, voffA); PG8_STAGE(PG8_SA(0, 1), cA + hstepA, voffA);
        if (wr == 1) PG8_BAR;
        PG8_WAIT_V(2); PG8_BAR;
        PG8_STAGE(PG8_SB(1, 0), cB + kstep, voffB); PG8_STAGE(PG8_SA(1, 0), cA + kstep, voffA); PG8_STAGE(PG8_SB(1, 1), cB + hstepB + kstep, voffB);
        PG8_WAIT_V(6); PG8_BAR;
    } else {
        PG8_STAGE(PG8_SB(0, 0), cB, voffB); PG8_STAGE(PG8_SA(0, 0), cA, voffA); PG8_STAGE(PG8_SB(0, 1), cB + hstepB, voffB); PG8_STAGE(PG8_SA(0, 1), cA + hstepA, voffA);
        if (wr == 1) PG8_BAR;
        PG8_WAIT_V(4); PG8_BAR;
        PG8_STAGE(PG8_SB(1, 0), cB + kstep, voffB); PG8_STAGE(PG8_SA(1, 0), cA + kstep, voffA); PG8_STAGE(PG8_SB(1, 1), cB + hstepB + kstep, voffB);
        PG8_WAIT_V(6); PG8_BAR;
    }
    for (;;) {
        const bool has_next = S.next(ui + 1, nxt);
        const char* nA = has_next ? (const char*)g.A + (size_t)nxt.pm * tstepA : cA; const char* nB = has_next ? (const char*)g.Bt + (size_t)nxt.pn * tstepB : cB;
        for (int t = 0; t < nt; t += 2) {
            const bool last = (t == nt - 2);
            const char* a1 = cA + (size_t)(t + 1) * kstep;
            const char* a2 = last ? nA : cA + (size_t)(t + 2) * kstep; const char* b2 = last ? nB : cB + (size_t)(t + 2) * kstep;
            const char* a3 = a2 + kstep; const char* b3 = b2 + kstep;
            if (last && has_next) S.a_ready(nxt);
            if constexpr (SP2) {
            PG8_LDB(B0, 0, 0); PG8_LDB(B1, 0, 1); PG8_SCHED; PG8_LDA(At, 0, 0); PG8_STAGE(PG8_SA(1, 1), a1 + hstepA, voffA);
            PG8_WAIT_V(8); PG8_WAIT_L(0); PG8_BAR; PG8_MMA(0, 0, At, B0); PG8_MMA(0, 1, At, B1); PG8_BAR; PG8_SCHED;
            PG8_LDA(At, 0, 1); PG8_STAGE(PG8_SB(0, 0), b2, voffB); PG8_STAGE(PG8_SB(0, 1), b2 + hstepB, voffB); PG8_STAGE(PG8_SA(0, 0), a2, voffA);
            PG8_WAIT_V(8); PG8_WAIT_L(0); PG8_BAR; PG8_MMA(1, 0, At, B0); PG8_MMA(1, 1, At, B1); PG8_BAR; PG8_SCHED;
            PG8_LDB(B0, 1, 0); PG8_LDB(B1, 1, 1); PG8_SCHED; PG8_LDA(At, 1, 0); PG8_STAGE(PG8_SA(0, 1), a2 + hstepA, voffA);
            PG8_WAIT_V(8); PG8_WAIT_L(0); PG8_BAR; PG8_MMA(0, 0, At, B0); PG8_MMA(0, 1, At, B1); PG8_BAR; PG8_SCHED;
            PG8_LDA(At, 1, 1); PG8_STAGE(PG8_SB(1, 0), b3, voffB); PG8_STAGE(PG8_SB(1, 1), b3 + hstepB, voffB); PG8_STAGE(PG8_SA(1, 0), a3, voffA);
            PG8_WAIT_V(8); PG8_WAIT_L(0); PG8_BAR; PG8_MMA(1, 0, At, B0); PG8_MMA(1, 1, At, B1); PG8_BAR; PG8_SCHED;
            } else {
            PG8_LDB(B0, 0, 0); PG8_SCHED; PG8_LDA(At, 0, 0); PG8_STAGE(PG8_SA(1, 1), a1 + hstepA, voffA);
            PG8_WAIT_L(8); PG8_BAR; PG8_WAIT_L(0); PG8_MMA(0, 0, At, B0); PG8_BAR; PG8_SCHED;
            PG8_LDB(B1, 0, 1); PG8_STAGE(PG8_SB(0, 0), b2, voffB);
            PG8_BAR; PG8_WAIT_L(0); PG8_MMA(0, 1, At, B1); PG8_BAR;
            PG8_LDA(At, 0, 1); PG8_STAGE(PG8_SA(0, 0), a2, voffA);
            PG8_BAR; PG8_WAIT_L(0); PG8_MMA(1, 0, At, B0); PG8_BAR; PG8_SCHED;
            PG8_STAGE(PG8_SB(0, 1), b2 + hstepB, voffB);
            PG8_WAIT_V(6); PG8_BAR; PG8_MMA(1, 1, At, B1); PG8_BAR;
            PG8_LDB(B0, 1, 0); PG8_SCHED; PG8_LDA(At, 1, 0); PG8_STAGE(PG8_SA(0, 1), a2 + hstepA, voffA);
            PG8_WAIT_L(8); PG8_BAR; PG8_WAIT_L(0); PG8_MMA(0, 0, At, B0); PG8_BAR; PG8_SCHED;
            PG8_LDB(B1, 1, 1); PG8_STAGE(PG8_SB(1, 0), b3, voffB);
            PG8_BAR; PG8_WAIT_L(0); PG8_MMA(0, 1, At, B1); PG8_BAR;
            PG8_LDA(At, 1, 1); PG8_STAGE(PG8_SA(1, 0), a3, voffA);
            PG8_BAR; PG8_WAIT_L(0); PG8_MMA(1, 0, At, B0); PG8_BAR; PG8_SCHED;
            PG8_STAGE(PG8_SB(1, 1), b3 + hstepB, voffB);
            PG8_WAIT_V(6); PG8_BAR; PG8_MMA(1, 1, At, B1); PG8_BAR;
            }
        }
        if constexpr (ALIGN_EPI) { if (wr == 0) PG8_BAR; }
        if constexpr (!Epi::AFTER_DRAIN) { E(acc, cur, wr, wc, fr, fq); S.done(cur); }
        if (!has_next) break;
#pragma unroll
        for (int a = 0; a < 2; ++a)
#pragma unroll
            for (int b = 0; b < 2; ++b)
#pragma unroll
                for (int m = 0; m < 4; ++m)
#pragma unroll
                    for (int n = 0; n < 2; ++n) acc[a][b][m][n] = (f32x4){0.f, 0.f, 0.f, 0.f};
        cur = nxt; cA = nA; cB = nB; ++ui;
        if constexpr (ALIGN_EPI) { if (wr == 1) PG8_BAR; }
    }
    PG8_WAIT_V(0);
    if constexpr (!ALIGN_EPI) { if (wr == 0) PG8_BAR; }
    PG8_BAR;
    if constexpr (Epi::AFTER_DRAIN) { E.fused(acc, cur, wr, wc, fr, fq, lds, wid, lane); S.done(cur); }
#undef PG8_SA
#undef PG8_SB
#undef PG8_STAGE
#undef PG8_LDA
#undef PG8_LDB
#undef PG8_MMA
#undef PG8_WAIT_V
#undef PG8_WAIT_L
#undef PG8_BAR
#undef PG8_SCHED
}
}
#include <hip/hip_bf16.h>
#include <cmath>
namespace attn_body {
using bf16=__hip_bfloat16;
using bf16x8=__attribute__((ext_vector_type(8)))short;
using s16x4=__attribute__((ext_vector_type(4)))short;
using f32x16=__attribute__((ext_vector_type(16)))float;
using u32x4=__attribute__((ext_vector_type(4)))unsigned;
constexpr int D=64;
constexpr int PQ=3584, PKV=3584, PO=1536;
constexpr int NW=8,QBLK=32,QB=QBLK*NW,KVBLK=64;
__device__ __forceinline__ int crow(int r,int hi){return (r&3)+8*(r>>2)+4*hi;}
#define SBAR() __builtin_amdgcn_sched_barrier(0)
constexpr int NSLOT=3, SLOTB=8192;
constexpr int LDS_K=0, LDS_V=NSLOT*SLOTB, LDS_WS=2*NSLOT*SLOTB, LDS_OST=LDS_WS+NW*64*4, LDS_BYTES=LDS_OST+NW*4096;
constexpr float C2=0.125f*1.4426950408889634f;
__device__ __forceinline__ void glds16(const void*gsrc,unsigned lds_dst){unsigned keep;
  asm volatile("s_mov_b32 %0, m0\n\ts_mov_b32 m0, %2\n\ts_nop 0\n\tglobal_load_lds_dwordx4 %1, off\n\ts_mov_b32 m0, %0":"=&s"(keep):"v"(gsrc),"s"(lds_dst):"memory");}
__device__ __forceinline__ float max3f(float a,float b,float c){float r;asm("v_max3_f32 %0, %1, %2, %3":"=v"(r):"v"(a),"v"(b),"v"(c));return r;}
__device__ __forceinline__ float max2f(float a,float b){float r;asm("v_max_f32_e32 %0, %1, %2":"=v"(r):"v"(a),"v"(b));return r;}
__device__ __forceinline__ float fadd_s(float a,float b){float r;asm("v_add_f32_e32 %0, %1, %2":"=v"(r):"v"(a),"v"(b));return r;}
__device__ __forceinline__ float fsub_s(float a,float b){float r;asm("v_sub_f32_e32 %0, %1, %2":"=v"(r):"v"(a),"v"(b));return r;}
typedef float f32x2_t __attribute__((ext_vector_type(2))); typedef __bf16 bf16x2_t __attribute__((ext_vector_type(2)));
__device__ __forceinline__ unsigned cvtpk_s(float lo,float hi){f32x2_t v={lo,hi};bf16x2_t b=__builtin_convertvector(v,bf16x2_t);return __builtin_bit_cast(unsigned,b);}
#define WAIT_BAR(N) asm volatile("s_waitcnt vmcnt(" #N ") lgkmcnt(0)\n\ts_barrier":::"memory")

__device__ __forceinline__ void qkt(f32x16&p0,f32x16&p1,const char*Kslot,const bf16x8*qr,const f32x16&negm,int r32,int hi){
  const char*kb=Kslot+hi*1024+r32*16;
  #pragma unroll
  for(int d0=0;d0<4;++d0){
    const bf16x8 b0=*reinterpret_cast<const bf16x8*>(kb+d0*2048);
    const bf16x8 b1=*reinterpret_cast<const bf16x8*>(kb+d0*2048+512);
    if(d0==0){p0=__builtin_amdgcn_mfma_f32_32x32x16_bf16(b0,qr[0],negm,0,0,0);p1=__builtin_amdgcn_mfma_f32_32x32x16_bf16(b1,qr[0],negm,0,0,0);}
    else{p0=__builtin_amdgcn_mfma_f32_32x32x16_bf16(b0,qr[d0],p0,0,0,0);p1=__builtin_amdgcn_mfma_f32_32x32x16_bf16(b1,qr[d0],p1,0,0,0);}}
}
typedef __attribute__((address_space(3))) const char* lds_cptr;
typedef short v4i16_t __attribute__((ext_vector_type(4)));
__device__ __forceinline__ void kload8(bf16x8*kf,lds_cptr kp){
  kf[0]=*(const __attribute__((address_space(3))) bf16x8*)(kp);      kf[1]=*(const __attribute__((address_space(3))) bf16x8*)(kp+512);
  kf[2]=*(const __attribute__((address_space(3))) bf16x8*)(kp+2048); kf[3]=*(const __attribute__((address_space(3))) bf16x8*)(kp+2560);
  kf[4]=*(const __attribute__((address_space(3))) bf16x8*)(kp+4096); kf[5]=*(const __attribute__((address_space(3))) bf16x8*)(kp+4608);
  kf[6]=*(const __attribute__((address_space(3))) bf16x8*)(kp+6144); kf[7]=*(const __attribute__((address_space(3))) bf16x8*)(kp+6656);
}
__device__ __forceinline__ void kload2(bf16x8*kf,lds_cptr kp,int j){ kf[2*j]=*(const __attribute__((address_space(3))) bf16x8*)(kp+j*2048); kf[2*j+1]=*(const __attribute__((address_space(3))) bf16x8*)(kp+j*2048+512); }
__device__ __forceinline__ s16x4 vtr(lds_cptr p){ return __builtin_bit_cast(s16x4,__builtin_amdgcn_ds_read_tr16_b64_v4i16((__attribute__((address_space(3))) v4i16_t*)p)); }
__device__ __forceinline__ float rowmax(const f32x16&p0,const f32x16&p1){
  float a=max3f(p0[0],p0[1],p1[0]),b=max3f(p0[2],p0[3],p1[1]);a=max3f(a,p1[2],p1[3]);
  #pragma unroll
  for(int r=4;r<16;r+=4){a=max3f(a,p0[r],p0[r+1]);b=max3f(b,p0[r+2],p0[r+3]);a=max3f(a,p1[r],p1[r+1]);b=max3f(b,p1[r+2],p1[r+3]);}
  const float m=max2f(a,b);
  auto rr=__builtin_amdgcn_permlane32_swap(__float_as_uint(m),__float_as_uint(m),false,false);
  return max2f(__uint_as_float(rr[0]),__uint_as_float(rr[1]));
}
__device__ __forceinline__ void pv(f32x16*o,int vb,bf16x8 pa0,bf16x8 pa1,bf16x8 pa2,bf16x8 pa3){
  #pragma unroll
  for(int d0=0;d0<2;++d0){s16x4 lo[4],hi[4];
    #pragma unroll
    for(int ks=0;ks<4;++ks){
      asm volatile("ds_read_b64_tr_b16 %0,%1 offset:%c2":"=&v"(lo[ks]):"v"(vb),"i"(d0*4096+ks*1024):"memory");
      asm volatile("ds_read_b64_tr_b16 %0,%1 offset:%c2":"=&v"(hi[ks]):"v"(vb),"i"(d0*4096+ks*1024+512):"memory");}
    asm volatile("s_waitcnt lgkmcnt(0)":::"memory");SBAR();
    #define PK(k) (bf16x8){lo[k][0],lo[k][1],lo[k][2],lo[k][3],hi[k][0],hi[k][1],hi[k][2],hi[k][3]}
    o[d0]=__builtin_amdgcn_mfma_f32_32x32x16_bf16(pa0,PK(0),o[d0],0,0,0);
    o[d0]=__builtin_amdgcn_mfma_f32_32x32x16_bf16(pa1,PK(1),o[d0],0,0,0);
    o[d0]=__builtin_amdgcn_mfma_f32_32x32x16_bf16(pa2,PK(2),o[d0],0,0,0);
    o[d0]=__builtin_amdgcn_mfma_f32_32x32x16_bf16(pa3,PK(3),o[d0],0,0,0);
    #undef PK
  }
}

#ifndef ATTN_STORE16
#define ATTN_STORE16(p,v) (*(u32x4*)(p)=(v))
#endif
template<int THRL> __device__ __forceinline__ void attn_unit(const bf16*Qblk,const bf16*__restrict__ Kh,const bf16*__restrict__ Vh,bf16*Oblk,const int NT,char*shm){
  int tid=threadIdx.x; asm volatile("":"+v"(tid)); const int lane=tid&63,r32=lane&31,hi=lane>>5; const int wid=__builtin_amdgcn_readfirstlane(tid>>6);
  const bf16*Qw=Qblk+(long)(wid*QBLK)*PQ;
  const unsigned lds0=(unsigned)(uintptr_t)shm;
  float*wsf=(float*)(shm+LDS_WS)+wid*64;
  const bf16*ksrc=Kh+(long)lane*PKV+wid*8;
  const bf16*vsrc=Vh+(long)(16*(wid&3)+(lane>>2))*PKV+(wid>>2)*32+(lane&3)*8;
  const unsigned kdst=lds0+LDS_K+wid*1024, vdst=lds0+LDS_V+wid*1024;
  #define DMA_K(t,slot) glds16(ksrc+(long)(t)*KVBLK*PKV,(unsigned)__builtin_amdgcn_readfirstlane(kdst+(slot)))
  #define DMA_V(t,slot) glds16(vsrc+(long)(t)*KVBLK*PKV,(unsigned)__builtin_amdgcn_readfirstlane(vdst+(slot)))
  const int vb0=(int)(lds0+LDS_V)+((lane>>4)&1)*32+(lane&3)*8+(4*hi+((lane&15)>>2))*64;
  const char*Kbase=shm+LDS_K; bf16x8 kf[8];
  const lds_cptr shm3=(lds_cptr)shm; const lds_cptr kp0=shm3+LDS_K+hi*1024+r32*16; const lds_cptr vp0=shm3+LDS_V+((lane>>4)&1)*32+(lane&3)*8+(4*hi+((lane&15)>>2))*64;
  DMA_K(0,0);DMA_V(0,0);DMA_K(1,SLOTB);
  bf16x8 qr[4];
  #pragma unroll
  for(int d0=0;d0<4;++d0)qr[d0]=*reinterpret_cast<const bf16x8*>(&Qw[(long)r32*PQ+d0*16+hi*8]);
  float mhat=0.f,l_reg=0.f;f32x16 o[2];o[0]=f32x16{};o[1]=f32x16{};f32x16 negm=f32x16{};asm volatile("":"+v"(negm));
  #define CMASK(P0,P1,t) do{}while(0)
  bool resc=false;
  #define START(P0,P1) do{ const float rm=rowmax(P0,P1); resc=false; \
    { const float dl=rm; mhat=fadd_s(mhat,dl); \
      _Pragma("unroll") for(int r=0;r<16;++r){P0[r]=fsub_s(P0[r],dl);P1[r]=fsub_s(P1[r],dl);} \
      _Pragma("unroll") for(int r=0;r<16;++r)negm[r]=-mhat; asm volatile("":"+v"(negm)); } \
    _Pragma("unroll") for(int r=0;r<16;++r)P0[r]=__builtin_amdgcn_exp2f(P0[r]); }while(0)
  #define RESC() do{ if(resc){ asm volatile("s_waitcnt lgkmcnt(0)":::"memory"); \
      _Pragma("unroll") for(int d_=0;d_<2;++d_) _Pragma("unroll") for(int r=0;r<16;++r)o[d_][r]*=wsf[crow(r,hi)]; } }while(0)
  f32x16 pA0,pA1,pB0,pB1;
  int sl_prev=0,sl_cur=0,sl_next=SLOTB;
  #define ROT() do{sl_prev=sl_cur;sl_cur=sl_next;sl_next=(sl_next==(NSLOT-1)*SLOTB)?0:sl_next+SLOTB;}while(0)
  DMA_K(2,2*SLOTB);
  WAIT_BAR(3);
  qkt(pA0,pA1,Kbase,qr,negm,r32,hi);asm volatile("s_nop 15\n\ts_nop 7":"+v"(pA0),"+v"(pA1));CMASK(pA0,pA1,0);
  START(pA0,pA1);
  _Pragma("unroll") for(int r=0;r<16;++r)pA1[r]=__builtin_amdgcn_exp2f(pA1[r]);
  WAIT_BAR(0);
  DMA_K(3,0);DMA_V(1,SLOTB);
  ROT();
  kload8(kf,kp0+sl_cur);
  WAIT_BAR(2);
  s16x4 vlo[8],vhi[8]; u32x4 pw0,pw1,pw2,pw3;
  #define PKW(P,B) cvtpk_s(P[B],P[B+1])
  #define PAF(k) __builtin_bit_cast(bf16x8,pw##k)
  #define VFR(i) (bf16x8){vlo[i][0],vlo[i][1],vlo[i][2],vlo[i][3],vhi[i][0],vhi[i][1],vhi[i][2],vhi[i][3]}
  #define PIN(x) asm volatile("":"+v"(x))
  #define MX3(a,b,c) __builtin_fmaxf(__builtin_fmaxf((a),(b)),(c))
  #define GAPA(MF,A0,A1,A2,A3,W0,W1,PW) do{ MF; sacc+=A0; sacc+=A1; sacc+=A2; sacc+=A3; PIN(sacc); W0; W1; PIN(PW); SBAR(); }while(0)
  #define EX(v) __builtin_amdgcn_exp2f(v)
  #define GAPB(MF,X,B) do{ MF; X[B]=EX(X[B]); X[B+1]=EX(X[B+1]); X[B+2]=EX(X[B+2]); X[B+3]=EX(X[B+3]); PIN(X); SBAR(); }while(0)
  #define VRD(i) do{ vlo[i]=vtr(vp_+(((i)>>2)*4096+((i)&3)*1024)); vhi[i]=vtr(vp_+(((i)>>2)*4096+((i)&3)*1024+512)); }while(0)
  #define KRD(G,j) do{ if(G){ kload2(kf,kp0+sl_next,j); SBAR(); } }while(0)
  #define STEP(C0,C1,P0,P1,t,GK,GV,GL) do{ SBAR(); \
    const lds_cptr vp_=vp0+sl_prev; \
    VRD(0); SBAR(); float sacc=(P0[0]+P0[1]); \
    GAPA(C0=__builtin_amdgcn_mfma_f32_32x32x16_bf16(kf[0],qr[0],negm,0,0,0), P0[2],P0[3],P0[4],P0[5],     pw0[0]=PKW(P0,0), pw0[1]=PKW(P0,2), pw0); \
    VRD(4); SBAR(); GAPA(C1=__builtin_amdgcn_mfma_f32_32x32x16_bf16(kf[1],qr[0],negm,0,0,0), P0[6],P0[7],P0[8],P0[9],     pw0[2]=PKW(P0,4), pw0[3]=PKW(P0,6), pw0); \
    VRD(1); SBAR(); GAPA(C0=__builtin_amdgcn_mfma_f32_32x32x16_bf16(kf[2],qr[1],C0,0,0,0),   P0[10],P0[11],P0[12],P0[13], pw1[0]=PKW(P0,8), pw1[1]=PKW(P0,10), pw1); \
    VRD(5); SBAR(); GAPA(C1=__builtin_amdgcn_mfma_f32_32x32x16_bf16(kf[3],qr[1],C1,0,0,0),   P0[14],P0[15],P1[0],P1[1],   pw1[2]=PKW(P0,12),pw1[3]=PKW(P0,14), pw1); \
    VRD(2); SBAR(); GAPA(C0=__builtin_amdgcn_mfma_f32_32x32x16_bf16(kf[4],qr[2],C0,0,0,0),   P1[2],P1[3],P1[4],P1[5],     pw2[0]=PKW(P1,0), pw2[1]=PKW(P1,2), pw2); \
    VRD(6); SBAR(); GAPA(C1=__builtin_amdgcn_mfma_f32_32x32x16_bf16(kf[5],qr[2],C1,0,0,0),   P1[6],P1[7],P1[8],P1[9],     pw2[2]=PKW(P1,4), pw2[3]=PKW(P1,6), pw2); \
    VRD(3); SBAR(); GAPA(C0=__builtin_amdgcn_mfma_f32_32x32x16_bf16(kf[6],qr[3],C0,0,0,0),   P1[10],P1[11],P1[12],P1[13], pw3[0]=PKW(P1,8), pw3[1]=PKW(P1,10), pw3); \
    VRD(7); SBAR(); GAPA(C1=__builtin_amdgcn_mfma_f32_32x32x16_bf16(kf[7],qr[3],C1,0,0,0),   P1[14],P1[15],0.f,0.f,       pw3[2]=PKW(P1,12),pw3[3]=PKW(P1,14), pw3); \
    l_reg+=sacc; \
    if(GK){DMA_K((t)+3,sl_cur);} if(GV){DMA_V((t)+1,sl_next);} \
    CMASK(C0,C1,t); \
    { float a=MX3(C0[0],C0[1],C1[0]),b=MX3(C0[2],C0[3],C1[1]); a=MX3(a,C1[2],C1[3]); \
      _Pragma("unroll") for(int r=4;r<16;r+=4){a=MX3(a,C0[r],C0[r+1]);b=MX3(b,C0[r+2],C0[r+3]);a=MX3(a,C1[r],C1[r+1]);b=MX3(b,C1[r+2],C1[r+3]);} \
      float rm=__builtin_fmaxf(a,b); { auto rr=__builtin_amdgcn_permlane32_swap(__float_as_uint(rm),__float_as_uint(rm),false,false); rm=__builtin_fmaxf(__uint_as_float(rr[0]),__uint_as_float(rr[1])); } \
      resc=false; \
      if(__builtin_expect(__any(rm>(float)THRL),0)){ const float dl=__builtin_fmaxf(rm,0.f); mhat+=dl; \
        _Pragma("unroll") for(int r=0;r<16;++r){C0[r]-=dl;C1[r]-=dl;} \
        _Pragma("unroll") for(int r=0;r<16;++r)negm[r]=-mhat; asm volatile("":"+v"(negm)); \
        const float f=__builtin_amdgcn_exp2f(-dl); l_reg*=f; if(hi==0)wsf[r32]=f; resc=true; } } \
    SBAR(); \
    GAPB(o[0]=__builtin_amdgcn_mfma_f32_32x32x16_bf16(PAF(0),VFR(0),o[0],0,0,0), C0,0); \
    GAPB(o[1]=__builtin_amdgcn_mfma_f32_32x32x16_bf16(PAF(0),VFR(4),o[1],0,0,0), C0,4); \
    KRD(GL,0); GAPB(o[0]=__builtin_amdgcn_mfma_f32_32x32x16_bf16(PAF(1),VFR(1),o[0],0,0,0), C0,8); \
    KRD(GL,1); GAPB(o[1]=__builtin_amdgcn_mfma_f32_32x32x16_bf16(PAF(1),VFR(5),o[1],0,0,0), C0,12); \
    KRD(GL,2); GAPB(o[0]=__builtin_amdgcn_mfma_f32_32x32x16_bf16(PAF(2),VFR(2),o[0],0,0,0), C1,0); \
    KRD(GL,3); GAPB(o[1]=__builtin_amdgcn_mfma_f32_32x32x16_bf16(PAF(2),VFR(6),o[1],0,0,0), C1,4); \
    GAPB(o[0]=__builtin_amdgcn_mfma_f32_32x32x16_bf16(PAF(3),VFR(3),o[0],0,0,0), C1,8); \
    GAPB(o[1]=__builtin_amdgcn_mfma_f32_32x32x16_bf16(PAF(3),VFR(7),o[1],0,0,0), C1,12); \
    }while(0)
  int t=1;
  #undef CMASK
  #define CMASK(P0,P1,t) do{}while(0)
  for(;t+5<NT;t+=2){
    STEP(pB0,pB1,pA0,pA1,t,true,true,true);     WAIT_BAR(2); RESC(); ROT();
    STEP(pA0,pA1,pB0,pB1,t+1,true,true,true);   WAIT_BAR(2); RESC(); ROT();
  }
  #undef CMASK
  #define CMASK(P0,P1,t) do{}while(0)
  #define ENDW(tt) do{ if((tt)+3<NT){WAIT_BAR(2);} else if((tt)+2<NT){WAIT_BAR(1);} else {WAIT_BAR(0);} }while(0)
  for(;t+1<NT;t+=2){
    STEP(pB0,pB1,pA0,pA1,t,(t+3<NT),(t+1<NT),(t+1<NT));       ENDW(t);   RESC(); ROT();
    STEP(pA0,pA1,pB0,pB1,t+1,(t+4<NT),(t+2<NT),(t+2<NT));     ENDW(t+1); RESC(); ROT();
  }
  STEP(pB0,pB1,pA0,pA1,NT-1,false,false,false); RESC();
  { float sacc=pB0[0]+pB0[1]; _Pragma("unroll") for(int r=2;r<16;++r)sacc+=pB0[r]; _Pragma("unroll") for(int r=0;r<16;++r)sacc+=pB1[r]; l_reg+=sacc;
    pw0=(u32x4){PKW(pB0,0),PKW(pB0,2),PKW(pB0,4),PKW(pB0,6)};pw1=(u32x4){PKW(pB0,8),PKW(pB0,10),PKW(pB0,12),PKW(pB0,14)};pw2=(u32x4){PKW(pB1,0),PKW(pB1,2),PKW(pB1,4),PKW(pB1,6)};pw3=(u32x4){PKW(pB1,8),PKW(pB1,10),PKW(pB1,12),PKW(pB1,14)};
    SBAR(); pv(o,vb0+sl_cur,PAF(0),PAF(1),PAF(2),PAF(3)); }
  #undef PKW
  #undef PAF
  #undef VFR
  #undef PIN
  #undef MX3
  #undef GAPA
  #undef GAPB
  #undef EX
  #undef VRD
  #undef KRD
  #undef STEP
  #undef ENDW
  {auto rr=__builtin_amdgcn_permlane32_swap(__float_as_uint(l_reg),__float_as_uint(l_reg),false,false);l_reg=__uint_as_float(rr[0])+__uint_as_float(rr[1]);}
  if(hi==0)wsf[32+r32]=l_reg;asm volatile("s_waitcnt lgkmcnt(0)":::"memory");
  float rli[16];
  #pragma unroll
  for(int r=0;r<16;++r)rli[r]=__builtin_amdgcn_rcpf(wsf[32+crow(r,hi)]);
  bf16*Ow=Oblk+(long)(wid*QBLK)*PO;
  { bf16*stg=(bf16*)(shm+LDS_OST)+wid*2048;
    #pragma unroll
    for(int r=0;r<16;++r){const int orow=crow(r,hi);
      #pragma unroll
      for(int d0=0;d0<2;++d0)stg[orow*64+d0*32+r32]=__float2bfloat16(o[d0][r]*rli[r]);}
    asm volatile("s_waitcnt lgkmcnt(0)":::"memory");
    #pragma unroll
    for(int i=0;i<4;++i){const int row=i*8+(lane>>3),ch=lane&7; const u32x4 v=*(const u32x4*)(stg+row*64+ch*8); ATTN_STORE16(Ow+(long)row*PO+ch*8,v);} }
  asm volatile("s_waitcnt lgkmcnt(0)\n\ts_barrier":::"memory");
  #undef DMA_K
  #undef DMA_V
  #undef CMASK
  #undef START
  #undef RESC
  #undef ROT
}
#undef SBAR
#undef WAIT_BAR
}

typedef unsigned short bf16_t;
typedef float f32x4 __attribute__((ext_vector_type(4)));
typedef short bf16x8 __attribute__((ext_vector_type(8)));
typedef unsigned u32x4 __attribute__((ext_vector_type(4)));
#define LASP __attribute__((address_space(3)))

constexpr int D = 1024, NB = 4, SEQ = 8192, CTX = 256, TB = SEQ + CTX, M = NB * TB;
constexpr int INW = 6432, NMIX = 3360, PMW = 3584, NGATE = 3072, YW = 1536, FH = 2816, F2 = 5632;
constexpr int C_U = 0, C_V = 512, C_Q = 1024, C_K = 1536, C_VV = 1664, C_GQ = 1792, C_GK = 2048, C_GV = 2304, C_AF = 2816, C_AB = 2832, C_GR = 2848;
constexpr float EPS = 1e-6f;
constexpr int NTHR = 512, NWV = 8;
constexpr int LDS_BYTES = 147456, LDS_SLOT = 147392;
constexpr size_t MiB = 1u << 20;
constexpr size_t WS_CTL = 0, WS_MOD = 65536;
constexpr size_t W_MIX = 1 * MiB, W_GATE = W_MIX + (size_t)PMW * D * 2, W_BR = W_GATE + (size_t)NGATE * D * 2, W_OUT = W_BR + (size_t)3 * D * 512 * 2,
                 W_UP = W_OUT + (size_t)D * D * 2, W_DOWN = W_UP + (size_t)F2 * D * 2, W_END = W_DOWN + (size_t)D * FH * 2;
static_assert(W_END <= 36 * MiB, "weights");
constexpr int GLA_NSC = 17, GLA_UNITS_A = NB * 4 * 2 * GLA_NSC;
constexpr size_t WS_GU = 36 * MiB, WS_GD = 53 * MiB, WS_XC = 54 * MiB, WS_HB = 58 * MiB, WS_R = 124 * MiB;
constexpr size_t WS_PM = WS_R, WS_Y = WS_R + 231 * MiB, WS_G = WS_R, WS_A = WS_R, WS_HALO = 488 * MiB, WS_END = 512 * MiB;
static_assert((size_t)GLA_UNITS_A * 32768 <= 17 * MiB && (size_t)M * PMW * 2 == 231 * MiB && (size_t)M * F2 * 2 <= 364 * MiB && WS_HALO + (size_t)(M / 32) * F2 * 2 <= WS_END, "ws map");

struct KArgs { const float* in[26]; float* out; unsigned char* ws; };
__device__ __forceinline__ unsigned long long sgpr64(unsigned long long p) { unsigned lo = (unsigned)p, hi = (unsigned)(p >> 32); asm volatile("" : "+v"(lo), "+v"(hi)); lo = __builtin_amdgcn_readfirstlane(lo); hi = __builtin_amdgcn_readfirstlane(hi); return ((unsigned long long)hi << 32) | lo; }
__device__ __forceinline__ unsigned long long araw(const KArgs& a, int k) { asm volatile("" : "+s"(k)); return ((const unsigned long long*)&a)[k]; }
#define GASP __attribute__((address_space(1)))
__device__ __forceinline__ unsigned char* wsp(const KArgs& a) { return (unsigned char*)(GASP unsigned char*)araw(a, 27); }
__device__ __forceinline__ float* outp(const KArgs& a) { return (float*)(GASP float*)araw(a, 26); }
__device__ __forceinline__ const float* ain(const KArgs& a, int k) { asm volatile("" : "+s"(k)); return (const float*)(GASP const float*)(unsigned long long)a.in[k]; }

__device__ __forceinline__ int opaque(int x) { asm volatile("" : "+v"(x)); return x; }
typedef float f32x2_t_ __attribute__((ext_vector_type(2))); typedef __bf16 bf16x2_t_ __attribute__((ext_vector_type(2)));
__device__ __forceinline__ unsigned pk2(float lo, float hi) { f32x2_t_ v = {lo, hi}; bf16x2_t_ b = __builtin_convertvector(v, bf16x2_t_); return __builtin_bit_cast(unsigned, b); }
__device__ __forceinline__ unsigned f2bf(float f) { return pk2(f, 0.f) & 0xffffu; }
__device__ __forceinline__ float bf2f(unsigned b) { return __uint_as_float(b << 16); }
__device__ __forceinline__ float bflo(unsigned w) { return __uint_as_float(w << 16); }
__device__ __forceinline__ float bfhi(unsigned w) { return __uint_as_float(w & 0xffff0000u); }
__device__ __forceinline__ float wave_sum(float v) {
#pragma unroll
    for (int o = 1; o < 64; o <<= 1) v += __shfl_xor(v, o);
    return v;
}
__device__ __forceinline__ float fexp(float x) { return __builtin_amdgcn_exp2f(x * 1.4426950408889634f); }
__device__ __forceinline__ float flog(float x) { return __builtin_amdgcn_logf(x) * 0.6931471805599453f; }
__device__ __forceinline__ float sigmoidf_(float x) { return __builtin_amdgcn_rcpf(1.0f + fexp(-x)); }
__device__ __forceinline__ float siluf_(float x) { return x * __builtin_amdgcn_rcpf(1.0f + fexp(-x)); }
__device__ __forceinline__ float gelu_tanh(float x) { const float y = 0.7978845608028654f * (x + 0.044715f * x * x * x); const float t = 1.0f - 2.0f * __builtin_amdgcn_rcpf(1.0f + fexp(2.0f * y)); return 0.5f * x * (1.0f + t); }

struct XPtrs { const float* in_lat; const float* in_ctx; float* out_lat; float* out_ctx; };
__device__ __forceinline__ XPtrs xptrs(const KArgs& a, int l) {
    XPtrs x; float* xc = (float*)(wsp(a) + WS_XC);
    x.in_lat = l == 0 ? ain(a, 0) : outp(a); x.in_ctx = l == 0 ? ain(a, 2) : xc; x.out_lat = outp(a); x.out_ctx = xc; return x;
}

namespace pg8 {
template <int ACT, bool HALO> struct EpiStore {
    static constexpr bool PERM = true, AFTER_DRAIN = false;
    bf16_t* O; int ldc; bf16_t* halo;
    __device__ __forceinline__ void operator()(const f32x4 (&acc)[2][2][4][2], const Unit& u, int wr, int wc, int fr, int fq) const {
        const int row0 = u.pm * BM + wr * 64 + fr, col0 = u.pn * BM + wc * 32 + 8 * fq;
#pragma unroll
        for (int ai = 0; ai < 2; ++ai)
#pragma unroll
            for (int m = 0; m < 4; ++m) {
                const int r = row0 + ai * HALF + m * 16; bf16_t* rowp = O + (size_t)r * ldc + col0;
                const bool hz = HALO && (((m & 1) == 0 && fr == 0) || ((m & 1) == 1 && fr == 15));
#pragma unroll
                for (int bj = 0; bj < 2; ++bj) {
                    f32x4 v0 = acc[ai][bj][m][0], v1 = acc[ai][bj][m][1];
                    if (ACT == 2) {
#pragma unroll
                        for (int e = 0; e < 4; ++e) { v0[e] = sigmoidf_(v0[e]); v1[e] = sigmoidf_(v1[e]); }
                    }
                    u32x4 w; w.x = pk2(v0[0], v0[1]); w.y = pk2(v0[2], v0[3]); w.z = pk2(v1[0], v1[1]); w.w = pk2(v1[2], v1[3]);
                    *(u32x4*)(rowp + bj * HALF) = w;
                    if (hz) *(u32x4*)(halo + (size_t)((r >> 5) * 2 + (m & 1)) * ldc + col0 + bj * HALF) = w;
                }
            }
    }
};
struct EpiBranch {
    static constexpr bool PERM = true, AFTER_DRAIN = false;
    bf16_t* Mg; const bf16_t* G; int first;
    __device__ __forceinline__ void operator()(const f32x4 (&acc)[2][2][4][2], const Unit& u, int wr, int wc, int fr, int fq) const {
        const int row0 = u.pm * BM + wr * 64 + fr, col0 = u.pn * BM + wc * 32 + 8 * fq;
#pragma unroll
        for (int ai = 0; ai < 2; ++ai)
#pragma unroll
            for (int m = 0; m < 4; ++m) {
                const int r = row0 + ai * HALF + m * 16;
#pragma unroll
                for (int bj = 0; bj < 2; ++bj) {
                    const int c = col0 + bj * HALF;
                    const u32x4 g = *(const u32x4*)(G + (size_t)r * NGATE + c);
                    u32x4 o = (u32x4){0u, 0u, 0u, 0u};
                    if (!first) o = *(const u32x4*)(Mg + (size_t)r * D + c);
                    const f32x4 v0 = acc[ai][bj][m][0], v1 = acc[ai][bj][m][1];
                    u32x4 w;
                    w.x = pk2(bflo(o.x) + bflo(g.x) * v0[0], bfhi(o.x) + bfhi(g.x) * v0[1]);
                    w.y = pk2(bflo(o.y) + bflo(g.y) * v0[2], bfhi(o.y) + bfhi(g.y) * v0[3]);
                    w.z = pk2(bflo(o.z) + bflo(g.z) * v1[0], bfhi(o.z) + bfhi(g.z) * v1[1]);
                    w.w = pk2(bflo(o.w) + bflo(g.w) * v1[2], bfhi(o.w) + bfhi(g.w) * v1[3]);
                    *(u32x4*)(Mg + (size_t)r * D + c) = w;
                }
            }
    }
};
struct EpiResid {
    static constexpr bool PERM = false, AFTER_DRAIN = false;
    XPtrs X; const float* modl; int gidx; const float* zeros;
    __device__ __forceinline__ void operator()(const f32x4 (&acc)[2][2][4][2], const Unit& u, int wr, int wc, int fr, int fq) const {
        const int b = u.pm / 33, tp = u.pm % 33;
        const float* xin; float* xout; int mr;
        if (tp == 0) { xin = X.in_ctx + (size_t)b * CTX * D; xout = X.out_ctx + (size_t)b * CTX * D; mr = 4; }
        else { const size_t o = ((size_t)b * SEQ + (size_t)(tp - 1) * 256) * D; xin = X.in_lat + o; xout = X.out_lat + o; mr = b; }
        const float* gate = zeros ? zeros : modl + (size_t)mr * 6 * D + (size_t)gidx * D;
        const int col0 = u.pn * BM + wc * 32 + 4 * fq;
#pragma unroll
        for (int bj = 0; bj < 2; ++bj)
#pragma unroll
            for (int n = 0; n < 2; ++n) {
                const int c = col0 + bj * HALF + 16 * n;
                const f32x4 gv = *(const f32x4*)(gate + c);
#pragma unroll
                for (int ai = 0; ai < 2; ++ai)
#pragma unroll
                    for (int m = 0; m < 4; ++m) {
                        const int rr = ai * HALF + wr * 64 + m * 16 + fr;
                        const f32x4 xv = *(const f32x4*)(xin + (size_t)rr * D + c);
                        *(f32x4*)(xout + (size_t)rr * D + c) = xv + gv * acc[ai][bj][m][n];
                        if (m == 3) __builtin_amdgcn_sched_barrier(0);
                    }
            }
    }
};
struct RowOrder {
    StaticOrder s; int lat;
    __device__ void init(int N, int G_, int c_, int lat_) { lat = lat_; s.init(lat_ ? 128 * BM : M, N, G_, c_); }
    __device__ bool next(int i, Unit& u) const { if (!s.next(i, u)) return false; if (lat) u.pm = (u.pm >> 5) * 33 + 1 + (u.pm & 31); return true; }
    __device__ __forceinline__ void a_ready(const Unit&) const {}
    __device__ __forceinline__ void done(const Unit&) const {}
};
}

__device__ __forceinline__ void transpose_item(const float* W, int ldw, int c0, int nvalid, int K, bf16_t* WT, float* scr, int kb, int nb, int lane) {
    const int k0 = 64 * kb, n0 = 32 * nb;
#pragma unroll 8
    for (int i = 0; i < 32; ++i) { const int kk = 2 * i + (lane >> 5), n = n0 + (lane & 31); scr[kk * 33 + (lane & 31)] = (n < nvalid) ? W[(size_t)(k0 + kk) * ldw + c0 + n] : 0.f; }
    asm volatile("s_waitcnt lgkmcnt(0)" ::: "memory");
    const int c = lane & 7;
#pragma unroll
    for (int j = 0; j < 4; ++j) { const int n = (lane >> 3) + 8 * j; const float* s = scr + (8 * c) * 33 + n;
        u32x4 o; o.x = pk2(s[0 * 33], s[1 * 33]); o.y = pk2(s[2 * 33], s[3 * 33]); o.z = pk2(s[4 * 33], s[5 * 33]); o.w = pk2(s[6 * 33], s[7 * 33]);
        *(u32x4*)(WT + (size_t)(n0 + n) * K + k0 + 8 * c) = o; }
    asm volatile("s_waitcnt lgkmcnt(0)" ::: "memory");
}
__device__ __forceinline__ void convert_weights(const KArgs& a, int l, char* lds, int gw, int ngw, int wave, int lane) {
    float* scr = (float*)(lds + wave * 8704);
    unsigned char* ws = a.ws;
    constexpr int I0 = 16 * 112, I1 = 16 * 96, I2 = 8 * 32, I5 = 16 * 32, I6 = 16 * 176, I7 = 44 * 32;
    constexpr int TOT = I0 + I1 + 3 * I2 + I5 + I6 + I7;
    for (int it = gw; it < TOT; it += ngw) {
        int r = it;
        if (r < I0) { transpose_item(ain(a, 8) + (size_t)l * D * INW, INW, 0, NMIX, D, (bf16_t*)(wsp(a) + W_MIX), scr, r / 112, r % 112, lane); continue; } r -= I0;
        if (r < I1) { transpose_item(ain(a, 8) + (size_t)l * D * INW, INW, NMIX, NGATE, D, (bf16_t*)(wsp(a) + W_GATE), scr, r / 96, r % 96, lane); continue; } r -= I1;
        if (r < 3 * I2) { const int bi = r / I2, rr = r % I2; transpose_item(ain(a, 17 + bi) + (size_t)l * 512 * D, D, 0, D, 512, (bf16_t*)(wsp(a) + W_BR) + (size_t)bi * D * 512, scr, rr / 32, rr % 32, lane); continue; } r -= 3 * I2;
        if (r < I5) { transpose_item(ain(a, 20) + (size_t)l * D * D, D, 0, D, D, (bf16_t*)(wsp(a) + W_OUT), scr, r / 32, r % 32, lane); continue; } r -= I5;
        if (r < I6) { transpose_item(ain(a, 21) + (size_t)l * D * F2, F2, 0, F2, D, (bf16_t*)(wsp(a) + W_UP), scr, r / 176, r % 176, lane); continue; } r -= I6;
        transpose_item(ain(a, 24) + (size_t)l * FH * D, D, 0, D, FH, (bf16_t*)(wsp(a) + W_DOWN), scr, r / 32, r % 32, lane);
    }
}

__device__ __forceinline__ void mods_phase(const KArgs& a, char* lds, int tid) {
    float* sc = (float*)lds;
    float* red = (float*)(lds + 20480);
    { const float* cin = ain(a, 1); const float* cctx = ain(a, 3);
    for (int e = tid; e < 5 * D; e += NTHR) { const int r = e >> 10, k = e & 1023; const float v = r < 4 ? cin[r * D + k] : cctx[k]; sc[e] = siluf_(v); } }
    __syncthreads();
    float* MOD = (float*)(wsp(a) + WS_MOD);
    const float* bada = ain(a, 5);
    const int col = tid & 63, kg = tid >> 6;
    for (int strip = blockIdx.x; strip < 192; strip += gridDim.x) {
        const int l = strip / 96, n = (strip % 96) * 64 + col;
        const float* w = ain(a, 4) + (size_t)l * D * 6144 + n;
        float acc[5] = {0.f, 0.f, 0.f, 0.f, 0.f};
#pragma unroll 8
        for (int k = kg * 128; k < kg * 128 + 128; ++k) { const float wv = w[(size_t)k * 6144];
#pragma unroll
            for (int r = 0; r < 5; ++r) acc[r] += sc[r * D + k] * wv; }
#pragma unroll
        for (int r = 0; r < 5; ++r) red[(kg * 5 + r) * 64 + col] = acc[r];
        __syncthreads();
        if (tid < 320) { const int r = tid >> 6, c = tid & 63; float s = 0.f;
#pragma unroll
            for (int g = 0; g < 8; ++g) s += red[(g * 5 + r) * 64 + c];
            const int nn = (strip % 96) * 64 + c; MOD[((size_t)l * 5 + r) * 6144 + nn] = s + bada[(size_t)l * 6144 + nn]; }
        __syncthreads();
    }
}

__device__ __forceinline__ void norm_phase(const KArgs& a, int l, int which, const float* in_lat, const float* in_ctx, int gw, int ngw, int lane) {
    const float* g = ain(a, which == 1 ? 6 : 7) + (size_t)l * D;
    const float* MODl = (const float*)(wsp(a) + WS_MOD) + (size_t)l * 5 * 6144;
    bf16_t* HB = (bf16_t*)(wsp(a) + WS_HB);
    const int si = which == 1 ? 0 : 3;
    for (int r = gw; r < M; r += ngw) {
        const int b = r / TB, p = r % TB;
        const float* src = p < CTX ? in_ctx + ((size_t)b * CTX + p) * D : in_lat + ((size_t)b * SEQ + (p - CTX)) * D;
        const float* md = MODl + (size_t)(p < CTX ? 4 : b) * 6144;
        f32x4 v[4]; float ss = 0.f;
#pragma unroll
        for (int j = 0; j < 4; ++j) { v[j] = *(const f32x4*)(src + (lane + 64 * j) * 4); ss += (v[j][0] * v[j][0] + v[j][1] * v[j][1]) + (v[j][2] * v[j][2] + v[j][3] * v[j][3]); }
        const float rstd = __builtin_amdgcn_rsqf(wave_sum(ss) * (1.0f / D) + EPS);
#pragma unroll
        for (int j = 0; j < 4; ++j) {
            const int k = (lane + 64 * j) * 4;
            const f32x4 gv = *(const f32x4*)(g + k), sh = *(const f32x4*)(md + si * D + k), scl = *(const f32x4*)(md + (si + 1) * D + k);
            f32x4 h;
#pragma unroll
            for (int e = 0; e < 4; ++e) h[e] = (v[j][e] * rstd * gv[e]) * (1.0f + scl[e]) + sh[e];
            uint2 o; o.x = pk2(h[0], h[1]); o.y = pk2(h[2], h[3]);
            *(uint2*)(HB + (size_t)r * D + k) = o;
        }
    }
}

template <bool ISQ>
__device__ __forceinline__ void qk_item(bf16_t* PM, bf16_t* DUM, bool dry, int row, int head, int j, const float (&g)[8], const float (&invf)[2], const unsigned (&wv)[4]) {
    const int p = row % TB;
    bf16_t* base = PM + (size_t)row * PMW + C_Q + head * 64 + 2 * j;
    float x[8]; float ss = 0.f;
#pragma unroll
    for (int q = 0; q < 4; ++q) { x[2 * q] = bflo(wv[q]); x[2 * q + 1] = bfhi(wv[q]); ss += x[2 * q] * x[2 * q] + x[2 * q + 1] * x[2 * q + 1]; }
    ss += __shfl_xor(ss, 1); ss += __shfl_xor(ss, 2); ss += __shfl_xor(ss, 4);
    const float rstd = __builtin_amdgcn_rsqf(ss * (1.0f / 64.0f) + EPS);
    float y[8];
#pragma unroll
    for (int i = 0; i < 8; ++i) y[i] = x[i] * rstd * g[i];
    if (p >= CTX) {
        const int t = p - CTX;
#pragma unroll
        for (int ax = 0; ax < 2; ++ax) { const float pos = (float)(ax ? (t & 63) : (t >> 6));
#pragma unroll
            for (int e = 0; e < 2; ++e) { float rev = pos * invf[e] * 0.15915494309189535f; rev -= floorf(rev);
                const float sn = __builtin_amdgcn_sinf(rev), cs = __builtin_amdgcn_cosf(rev);
                const float x1 = y[4 * ax + e], x2 = y[4 * ax + 2 + e];
                y[4 * ax + e] = x1 * cs - x2 * sn; y[4 * ax + 2 + e] = x1 * sn + x2 * cs; } }
    }
    if (dry) base = DUM + (size_t)row * 640 + head * 64 + 2 * j;
#pragma unroll
    for (int q = 0; q < 4; ++q) *(unsigned*)(base + 16 * q) = pk2(y[2 * q], y[2 * q + 1]);
}
__device__ __forceinline__ void qk_phase(const KArgs& a, int l, int gw, int ngw, int lane, bool dry) {
    bf16_t* PM = (bf16_t*)(wsp(a) + WS_PM); bf16_t* DUM = (bf16_t*)(wsp(a) + WS_Y);
    const int j = lane & 7, item = lane >> 3;
    constexpr float C2 = 0.125f * 1.4426950408889634f;
    float gq[8], gk[8], invf[2];
    { const float* qg = ain(a, 9) + l * 64; const float* kg = ain(a, 10) + l * 64;
#pragma unroll
      for (int q = 0; q < 4; ++q)
#pragma unroll
          for (int e = 0; e < 2; ++e) { gq[2 * q + e] = qg[16 * q + 2 * j + e] * C2; gk[2 * q + e] = kg[16 * q + 2 * j + e]; } }
#pragma unroll
    for (int e = 0; e < 2; ++e) invf[e] = exp2f(-(float)(2 * j + e) * (13.287712379549449f / 16.0f));
    for (int r4 = gw * 4; r4 < M; r4 += ngw * 4) {
        unsigned wq[4][4], wk[4];
#pragma unroll
        for (int p = 0; p < 4; ++p)
#pragma unroll
            for (int q = 0; q < 4; ++q) wq[p][q] = *(const unsigned*)(PM + (size_t)(r4 + p) * PMW + C_Q + item * 64 + 2 * j + 16 * q);
#pragma unroll
        for (int q = 0; q < 4; ++q) wk[q] = *(const unsigned*)(PM + (size_t)(r4 + (item >> 1)) * PMW + C_Q + (8 + (item & 1)) * 64 + 2 * j + 16 * q);
#pragma unroll
        for (int p = 0; p < 4; ++p) qk_item<true>(PM, DUM, dry, r4 + p, item, j, gq, invf, wq[p]);
        qk_item<false>(PM, DUM, dry, r4 + (item >> 1), 8 + (item & 1), j, gk, invf, wk);
    }
}

__device__ __forceinline__ bf16x8 ldfrag(const bf16_t* base, int pitch, int row0, int k0, int lane) {
    return *(const bf16x8*)(base + (size_t)(row0 + (lane & 15)) * pitch + k0 + (lane >> 4) * 8);
}
__device__ __forceinline__ int swz(int row, int col) { return row * 72 + ((((col >> 3) ^ (row >> 3)) & 7) << 3) + (col & 7); }
__device__ __forceinline__ bf16x8 ldfrag_sw(const bf16_t* base, int row0, int k0, int lane) {
    const int row = row0 + (lane & 15), ch = (k0 >> 3) + (lane >> 4);
    return *(const bf16x8*)(base + row * 72 + (((ch ^ (row >> 3)) & 7) << 3));
}
#define MFMA16(a, b, c) __builtin_amdgcn_mfma_f32_16x16x32_bf16((a), (b), (c), 0, 0, 0)

constexpr int GL_W2 = 0, GL_LA = 4608, GL_QIN = 21248, GL_KIN = 30464, GL_KST = 39680, GL_ATT = 48896, GL_VT = 58112, GL_ST = 76544, GL_DEC = 94976, GL_OT = 95232, GL_END = 129024;
constexpr int GP = 72;

__device__ __forceinline__ void gla_load_w2(const KArgs& a, int l, int h, int dir, char* lds, int tid) {
    bf16_t* W2T = (bf16_t*)(lds + GL_W2); float* B2 = (float*)(lds + GL_W2 + 4096);
    const float* w = ain(a, 14) + ((size_t)(l * 2 + dir) * 16) * 256 + h * 64;
    const float* bal = ain(a, 15);
    for (int e = tid; e < 64 * 32; e += NTHR) { const int d = e >> 5, k = e & 31; const int kk = k - 16 * dir;
        W2T[e] = (kk >= 0 && kk < 16) ? (bf16_t)f2bf(w[(size_t)kk * 256 + d]) : (bf16_t)0; }
    if (tid < 64) B2[tid] = bal[(size_t)(l * 2 + dir) * 256 + h * 64 + tid];
    __syncthreads();
}

struct GlaRegs { u32x4 a0, qv, kv, v0, v1, r0v, r1v; };
template <bool PC>
__device__ __forceinline__ void gla_fetch(GlaRegs& R, const bf16_t* PM, int r0, int h, int dir, int tid) {
    const int i = tid >> 3, sub = tid & 7;
    const bf16_t* rowp = PM + (size_t)(r0 + i) * PMW;
    R.a0 = *(const u32x4*)(PM + (size_t)(r0 + (tid >> 7) * 16 + (tid & 15)) * PMW + C_AF + ((tid >> 4) & 3) * 8);
    if (PC) R.qv = *(const u32x4*)(rowp + C_GQ + h * 64 + sub * 8);
    R.kv = *(const u32x4*)(rowp + C_GK + h * 64 + sub * 8);
    R.v0 = *(const u32x4*)(rowp + C_GV + h * 128 + sub * 16); R.v1 = *(const u32x4*)(rowp + C_GV + h * 128 + sub * 16 + 8);
    if (PC && dir) { R.r0v = *(const u32x4*)(rowp + C_GR + h * 128 + sub * 16); R.r1v = *(const u32x4*)(rowp + C_GR + h * 128 + sub * 16 + 8); }
}
template <bool PC>
__device__ __forceinline__ void gla_step(char* lds, const bf16_t* PM, bf16_t* Y, const float* gng, int r0, int r0n, GlaRegs& R, int h, int dir, f32x4 (&s)[4], float (&dprod)[4], int tid, int lane, int w) {
    float* LA = (float*)(lds + GL_LA); float* DEC = (float*)(lds + GL_DEC); float* OT = (float*)(lds + GL_OT);
    bf16_t* QIN = (bf16_t*)(lds + GL_QIN); bf16_t* KIN = (bf16_t*)(lds + GL_KIN); bf16_t* KST = (bf16_t*)(lds + GL_KST);
    bf16_t* ATT = (bf16_t*)(lds + GL_ATT); bf16_t* VT = (bf16_t*)(lds + GL_VT); bf16_t* ST = (bf16_t*)(lds + GL_ST);
    const int i = tid >> 3, sub = tid & 7, l15 = lane & 15, q4 = lane >> 4;
    const bf16_t* rowp = PM + (size_t)(r0 + i) * PMW;
    const u32x4 a0 = R.a0, qv = R.qv, kv = R.kv, v0 = R.v0, v1 = R.v1, r0v = R.r0v, r1v = R.r1v;
    if (r0n >= 0) gla_fetch<PC>(R, PM, r0n, h, dir, tid);
    {
        const bf16_t* W2T = (const bf16_t*)(lds + GL_W2); const float* B2 = (const float*)(lds + GL_W2 + 4096);
        const bf16x8 af = __builtin_bit_cast(bf16x8, a0);
#pragma unroll
        for (int t2 = 0; t2 < 2; ++t2) { const int nj = 2 * (w & 1) + t2;
            const bf16x8 bfr = *(const bf16x8*)(W2T + (size_t)(nj * 16 + l15) * 32 + q4 * 8);
            const f32x4 z4 = MFMA16(af, bfr, ((f32x4){0.f, 0.f, 0.f, 0.f}));
            const float b2 = B2[nj * 16 + l15];
#pragma unroll
            for (int j = 0; j < 4; ++j) { const float z = z4[j] + b2; const float ls = fminf(z, 0.f) - flog(1.0f + fexp(-fabsf(z)));
                LA[((w >> 1) * 16 + q4 * 4 + j) * 65 + nj * 16 + l15] = ls * (1.0f / 16.0f); } }
    }
    __syncthreads();
    {
        float* SEG = OT;
        float p[8];
#pragma unroll
        for (int r = 0; r < 8; ++r) p[r] = LA[(w * 8 + r) * 65 + lane];
        if (!dir) {
#pragma unroll
            for (int r = 1; r < 8; ++r) p[r] += p[r - 1];
            SEG[w * 64 + lane] = p[7];
        } else {
#pragma unroll
            for (int r = 6; r >= 0; --r) p[r] += p[r + 1];
            SEG[w * 64 + lane] = p[0];
        }
        __syncthreads();
        float off = 0.f;
#pragma unroll
        for (int g = 0; g < 8; ++g) { const float sv = SEG[g * 64 + lane]; off += (dir ? (g > w) : (g < w)) ? sv : 0.f; }
#pragma unroll
        for (int r = 0; r < 8; ++r) LA[(w * 8 + r) * 65 + lane] = p[r] + off;
    }
    __syncthreads();
    {
        const int lastrow = dir ? 0 : 63;
        float qf[8], kf[8];
        qf[0] = bflo(qv.x); qf[1] = bfhi(qv.x); qf[2] = bflo(qv.y); qf[3] = bfhi(qv.y); qf[4] = bflo(qv.z); qf[5] = bfhi(qv.z); qf[6] = bflo(qv.w); qf[7] = bfhi(qv.w);
        kf[0] = bflo(kv.x); kf[1] = bfhi(kv.x); kf[2] = bflo(kv.y); kf[3] = bfhi(kv.y); kf[4] = bflo(kv.z); kf[5] = bfhi(kv.z); kf[6] = bflo(kv.w); kf[7] = bfhi(kv.w);
#pragma unroll
        for (int dd = 0; dd < 8; ++dd) { const int d = sub * 8 + dd; const float cum = LA[i * 65 + d], tot = LA[lastrow * 65 + d];
            if (PC) { QIN[i * GP + d] = (bf16_t)f2bf(qf[dd] * 0.125f * fexp(cum)); KIN[i * GP + d] = (bf16_t)f2bf(kf[dd] * fexp(-cum)); }
            KST[swz(d, i)] = (bf16_t)f2bf(kf[dd] * fexp(tot - cum));
            if (i == 0) DEC[d] = fexp(tot); }
        const unsigned vw[8] = {v0.x, v0.y, v0.z, v0.w, v1.x, v1.y, v1.z, v1.w};
#pragma unroll
        for (int e = 0; e < 8; ++e) { VT[swz(sub * 16 + 2 * e, i)] = (bf16_t)(vw[e] & 0xffffu); VT[swz(sub * 16 + 2 * e + 1, i)] = (bf16_t)(vw[e] >> 16); }
    }
    __syncthreads();
    f32x4 o[4];
    if (PC) {
        const int mi = w >> 1;
#pragma unroll
        for (int t2 = 0; t2 < 2; ++t2) { const int nj = 2 * (w & 1) + t2; f32x4 acc = (f32x4){0.f, 0.f, 0.f, 0.f};
#pragma unroll
            for (int k0 = 0; k0 < 64; k0 += 32) acc = MFMA16(ldfrag(QIN, GP, mi * 16, k0, lane), ldfrag(KIN, GP, nj * 16, k0, lane), acc);
#pragma unroll
            for (int j = 0; j < 4; ++j) { const int ii = mi * 16 + q4 * 4 + j, jj = nj * 16 + l15; const bool keep = dir ? (jj >= ii) : (jj <= ii);
                ATT[ii * GP + jj] = (bf16_t)f2bf(keep ? acc[j] : 0.f); } }
#pragma unroll
        for (int n = 0; n < 4; ++n)
#pragma unroll
            for (int j = 0; j < 4; ++j) ST[(16 * w + q4 * 4 + j) * GP + 16 * n + l15] = (bf16_t)f2bf(s[n][j]);
        __syncthreads();
#pragma unroll
        for (int m2 = 0; m2 < 4; ++m2) { f32x4 acc = (f32x4){0.f, 0.f, 0.f, 0.f};
#pragma unroll
            for (int k0 = 0; k0 < 64; k0 += 32) { acc = MFMA16(ldfrag(ATT, GP, m2 * 16, k0, lane), ldfrag_sw(VT, 16 * w, k0, lane), acc);
                acc = MFMA16(ldfrag(QIN, GP, m2 * 16, k0, lane), ldfrag(ST, GP, 16 * w, k0, lane), acc); }
            o[m2] = acc; }
    }
#pragma unroll
    for (int n = 0; n < 4; ++n) { const float dc = DEC[16 * n + l15]; f32x4 acc = s[n] * dc;
#pragma unroll
        for (int k0 = 0; k0 < 64; k0 += 32) acc = MFMA16(ldfrag_sw(VT, 16 * w, k0, lane), ldfrag_sw(KST, 16 * n, k0, lane), acc);
        s[n] = acc; dprod[n] *= dc; }
    if (PC) {
        bf16_t* yb = Y + (size_t)r0 * YW + 1024 + h * 128 + 16 * w + l15;
        if (!dir) {
#pragma unroll
            for (int m2 = 0; m2 < 4; ++m2)
#pragma unroll
                for (int j = 0; j < 4; ++j) yb[(size_t)(m2 * 16 + q4 * 4 + j) * YW] = (bf16_t)f2bf(o[m2][j]);
        } else {
#pragma unroll
            for (int m2 = 0; m2 < 4; ++m2)
#pragma unroll
                for (int j = 0; j < 4; ++j) { const int tok = m2 * 16 + q4 * 4 + j; OT[tok * 132 + 16 * w + l15] = o[m2][j] + bf2f(yb[(size_t)tok * YW]); }
            __syncthreads();
            float vals[16]; float ss = 0.f;
#pragma unroll
            for (int e = 0; e < 16; ++e) { vals[e] = OT[i * 132 + sub * 16 + e]; ss += vals[e] * vals[e]; }
            ss += __shfl_xor(ss, 1); ss += __shfl_xor(ss, 2); ss += __shfl_xor(ss, 4);
            const float rstd = __builtin_amdgcn_rsqf(ss * (1.0f / 128.0f) + EPS);
            const unsigned rw[8] = {r0v.x, r0v.y, r0v.z, r0v.w, r1v.x, r1v.y, r1v.z, r1v.w};
            unsigned ow[8];
#pragma unroll
            for (int e = 0; e < 8; ++e) { const float g0 = gng[h * 128 + sub * 16 + 2 * e], g1 = gng[h * 128 + sub * 16 + 2 * e + 1];
                ow[e] = pk2(vals[2 * e] * rstd * g0 * siluf_(bflo(rw[e])), vals[2 * e + 1] * rstd * g1 * siluf_(bfhi(rw[e]))); }
            bf16_t* yo = Y + (size_t)(r0 + i) * YW + 1024 + h * 128 + sub * 16;
            *(u32x4*)yo = (u32x4){ow[0], ow[1], ow[2], ow[3]}; *(u32x4*)(yo + 8) = (u32x4){ow[4], ow[5], ow[6], ow[7]};
        }
    }
    __syncthreads();
}
__device__ __forceinline__ void gla_sc_range(int sc, int& first, int& cnt) { if (sc == 0) { first = 0; cnt = 4; } else { first = 4 + (sc - 1) * 8; cnt = 8; } }

__device__ __forceinline__ void gla_unit_a(const KArgs& a, int l, int unit, char* lds, int tid, int lane, int w) {
    const int sc = unit % GLA_NSC, dir = (unit / GLA_NSC) & 1, h = (unit / (GLA_NSC * 2)) & 3, b = unit / (GLA_NSC * 8);
    const bf16_t* PM = (const bf16_t*)(wsp(a) + WS_PM);
    gla_load_w2(a, l, h, dir, lds, tid);
    f32x4 s[4]; float dprod[4];
#pragma unroll
    for (int n = 0; n < 4; ++n) { s[n] = (f32x4){0.f, 0.f, 0.f, 0.f}; dprod[n] = 1.f; }
    int first, cnt; gla_sc_range(sc, first, cnt);
    GlaRegs R; R.qv = (u32x4){0u, 0u, 0u, 0u}; R.r0v = R.qv; R.r1v = R.qv;
    gla_fetch<false>(R, PM, b * TB + (dir ? first + cnt - 1 : first) * 64, h, dir, tid);
    for (int q = 0; q < cnt; ++q) { const int c = dir ? first + cnt - 1 - q : first + q; const int cn = dir ? c - 1 : c + 1;
        gla_step<false>(lds, PM, nullptr, nullptr, b * TB + c * 64, q + 1 < cnt ? b * TB + cn * 64 : -1, R, h, dir, s, dprod, tid, lane, w); }
    float* Dg = (float*)(wsp(a) + WS_GD) + (size_t)unit * 64;
    float* U = (float*)(wsp(a) + WS_GU) + ((size_t)unit * 8 + w) * 1024;
#pragma unroll
    for (int n = 0; n < 4; ++n)
#pragma unroll
        for (int j = 0; j < 4; ++j) U[(n * 4 + j) * 64 + lane] = s[n][j];
    if (w == 0 && lane < 16) {
#pragma unroll
        for (int n = 0; n < 4; ++n) Dg[16 * n + lane] = dprod[n]; }
}
__device__ __forceinline__ void gla_unit_c(const KArgs& a, int l, int unit  , char* lds, int tid, int lane, int w) {
    const int sc = unit % GLA_NSC, h = (unit / GLA_NSC) & 3, b = unit / (GLA_NSC * 4);
    const bf16_t* PM = (const bf16_t*)(wsp(a) + WS_PM); bf16_t* Y = (bf16_t*)(wsp(a) + WS_Y);
    const float* gng = ain(a, 16) + (size_t)l * 512;
    int first, cnt; gla_sc_range(sc, first, cnt);
    for (int dir = 0; dir < 2; ++dir) {
        GlaRegs R; R.qv = (u32x4){0u, 0u, 0u, 0u}; R.r0v = R.qv; R.r1v = R.qv;
        gla_fetch<true>(R, PM, b * TB + (dir ? first + cnt - 1 : first) * 64, h, dir, tid);
        gla_load_w2(a, l, h, dir, lds, tid);
        f32x4 s[4]; float dprod[4];
#pragma unroll
        for (int n = 0; n < 4; ++n) { s[n] = (f32x4){0.f, 0.f, 0.f, 0.f}; dprod[n] = 1.f; }
        const int ubase = ((b * 4 + h) * 2 + dir) * GLA_NSC;
        const int nprev = sc == 0 ? 0 : (dir == 0 ? sc : 1 + (GLA_NSC - 1 - sc));
#pragma unroll 4
        for (int q = 0; q < nprev; ++q) {
            const int scp = dir == 0 ? q : (q == 0 ? 0 : GLA_NSC - q);
            const float* U = (const float*)(wsp(a) + WS_GU) + ((size_t)(ubase + scp) * 8 + w) * 1024;
            const float* Dg = (const float*)(wsp(a) + WS_GD) + (size_t)(ubase + scp) * 64;
#pragma unroll
            for (int n = 0; n < 4; ++n) { const float dc = Dg[16 * n + (lane & 15)];
#pragma unroll
                for (int j = 0; j < 4; ++j) s[n][j] = s[n][j] * dc + U[(n * 4 + j) * 64 + lane]; }
        }
        for (int q = 0; q < cnt; ++q) { const int c = dir ? first + cnt - 1 - q : first + q; const int cn = dir ? c - 1 : c + 1;
            gla_step<true>(lds, PM, Y, gng, b * TB + c * 64, q + 1 < cnt ? b * TB + cn * 64 : -1, R, h, dir, s, dprod, tid, lane, w); }
    }
}

constexpr int GM_P = 136;
__device__ __forceinline__ void gmlp_unit(const KArgs& a, int l, int unit, char* lds, int tid, int lane, int w) {
    const int g = unit & 3, n = (unit >> 2) % 66, b = unit / 264;
    const int r0 = b * TB + n * 128;
    const bf16_t* PM = (const bf16_t*)(wsp(a) + WS_PM); bf16_t* Y = (bf16_t*)(wsp(a) + WS_Y);
    bf16_t* VT = (bf16_t*)lds; bf16_t* WSs = (bf16_t*)(lds + 128 * GM_P * 2);
    {
        const int i = tid >> 2, part = tid & 3;
        const bf16_t* vp = PM + (size_t)(r0 + i) * PMW + C_V + g * 128 + part * 32;
        float vals[32]; float ss = 0.f;
#pragma unroll
        for (int q = 0; q < 4; ++q) { const u32x4 t = *(const u32x4*)(vp + q * 8); const unsigned tw[4] = {t.x, t.y, t.z, t.w};
#pragma unroll
            for (int e = 0; e < 4; ++e) { const float x0 = gelu_tanh(bflo(tw[e])), x1 = gelu_tanh(bfhi(tw[e])); vals[q * 8 + 2 * e] = x0; vals[q * 8 + 2 * e + 1] = x1; ss += x0 * x0 + x1 * x1; } }
        ss += __shfl_xor(ss, 1); ss += __shfl_xor(ss, 2);
        const float rstd = __builtin_amdgcn_rsqf(ss * (1.0f / 128.0f) + EPS);
        const float* ng = ain(a, 11) + (size_t)l * 512 + g * 128 + part * 32;
#pragma unroll
        for (int e = 0; e < 32; ++e) VT[(part * 32 + e) * GM_P + i] = (bf16_t)f2bf(vals[e] * rstd * ng[e]);
        const float* wsp = ain(a, 12) + (((size_t)l * 4 + g) * 128 + i) * 128 + part * 32;
#pragma unroll
        for (int q = 0; q < 4; ++q) { const f32x4 x0 = *(const f32x4*)(wsp + q * 8), x1 = *(const f32x4*)(wsp + q * 8 + 4);
            u32x4 o; o.x = pk2(x0[0], x0[1]); o.y = pk2(x0[2], x0[3]); o.z = pk2(x1[0], x1[1]); o.w = pk2(x1[2], x1[3]);
            *(u32x4*)(WSs + (size_t)i * GM_P + part * 32 + q * 8) = o; }
    }
    __syncthreads();
    {
        bf16x8 af[4];
#pragma unroll
        for (int kk = 0; kk < 4; ++kk) af[kk] = ldfrag(WSs, GM_P, 16 * w, kk * 32, lane);
        const int l15 = lane & 15, q4 = lane >> 4;
        const float* bs = ain(a, 13) + ((size_t)l * 4 + g) * 128;
        float* FT = (float*)(lds + 2 * 128 * GM_P * 2);
        float bsv[4];
#pragma unroll
        for (int j = 0; j < 4; ++j) bsv[j] = bs[16 * w + q4 * 4 + j];
#pragma unroll
        for (int nt = 0; nt < 8; ++nt) { f32x4 acc = (f32x4){0.f, 0.f, 0.f, 0.f};
#pragma unroll
            for (int kk = 0; kk < 4; ++kk) acc = MFMA16(af[kk], ldfrag(VT, GM_P, 16 * nt, kk * 32, lane), acc);
#pragma unroll
            for (int j = 0; j < 4; ++j) FT[(16 * w + q4 * 4 + j) * 132 + 16 * nt + l15] = acc[j] + bsv[j]; }
    }
    __syncthreads();
    {
        const int i = tid >> 2, part = tid & 3;
        const bf16_t* up = PM + (size_t)(r0 + i) * PMW + C_U + g * 128 + part * 32;
        bf16_t* yp = Y + (size_t)(r0 + i) * YW + g * 128 + part * 32;
        const float* fp = (const float*)(lds + 2 * 128 * GM_P * 2) + i * 132 + part * 32;
#pragma unroll
        for (int q = 0; q < 4; ++q) { const u32x4 t = *(const u32x4*)(up + q * 8); const unsigned tw[4] = {t.x, t.y, t.z, t.w};
            const f32x4 f0 = *(const f32x4*)(fp + q * 8), f1 = *(const f32x4*)(fp + q * 8 + 4);
            u32x4 o;
            o.x = pk2(gelu_tanh(bflo(tw[0])) * f0[0], gelu_tanh(bfhi(tw[0])) * f0[1]); o.y = pk2(gelu_tanh(bflo(tw[1])) * f0[2], gelu_tanh(bfhi(tw[1])) * f0[3]);
            o.z = pk2(gelu_tanh(bflo(tw[2])) * f1[0], gelu_tanh(bfhi(tw[2])) * f1[1]); o.w = pk2(gelu_tanh(bflo(tw[3])) * f1[2], gelu_tanh(bfhi(tw[3])) * f1[3]);
            *(u32x4*)(yp + q * 8) = o; }
    }
    __syncthreads();
}

__device__ __forceinline__ void unpack8(const u32x4 v, float (&f)[8]) { f[0] = bflo(v.x); f[1] = bfhi(v.x); f[2] = bflo(v.y); f[3] = bfhi(v.y); f[4] = bflo(v.z); f[5] = bfhi(v.z); f[6] = bflo(v.w); f[7] = bfhi(v.w); }
__device__ __forceinline__ void conv_phase(const KArgs& a, int l, int gt, int ngt, bool dry) {
    bf16_t* A = (bf16_t*)(wsp(a) + WS_A); bf16_t* HBd = (bf16_t*)(wsp(a) + WS_HB); const bf16_t* HL = (const bf16_t*)(wsp(a) + WS_HALO);
    const float* cw = ain(a, 22) + (size_t)l * 3 * F2; const float* cb = ain(a, 23) + (size_t)l * F2;
    constexpr int NCC = FH / 8, NRG = M / 32;
    for (int it = gt; it < NRG * NCC; it += ngt) {
        const int rg = it / NCC, c = (it % NCC) * 8;
        const int rs = rg * 32, p0 = rs % TB;
        const bool seg_start = (p0 == 0) || (p0 == CTX), seg_end = (p0 + 31 == CTX - 1) || (p0 + 31 == TB - 1);
        float w0g[8], w1g[8], w2g[8], bg[8], w0v[8], w1v[8], w2v[8], bv[8];
#define LD8(dst, src) do { const f32x4 t0_ = *(const f32x4*)(src), t1_ = *(const f32x4*)((src) + 4); dst[0] = t0_[0]; dst[1] = t0_[1]; dst[2] = t0_[2]; dst[3] = t0_[3]; dst[4] = t1_[0]; dst[5] = t1_[1]; dst[6] = t1_[2]; dst[7] = t1_[3]; } while (0)
        LD8(w0g, cw + c); LD8(w1g, cw + F2 + c); LD8(w2g, cw + 2 * F2 + c); LD8(bg, cb + c);
        LD8(w0v, cw + FH + c); LD8(w1v, cw + F2 + FH + c); LD8(w2v, cw + 2 * F2 + FH + c); LD8(bv, cb + FH + c);
#undef LD8
        u32x4 pgw = (u32x4){0u, 0u, 0u, 0u}, pvw = pgw, cgw, cvw;
        if (!seg_start) { const bf16_t* hp = HL + (size_t)((rg - 1) * 2 + 1) * F2 + c; pgw = *(const u32x4*)hp; pvw = *(const u32x4*)(hp + FH); }
        { const bf16_t* cp = A + (size_t)rs * F2 + c; cgw = *(const u32x4*)cp; cvw = *(const u32x4*)(cp + FH); }
        for (int t0 = 0; t0 < 32; t0 += 4) {
            u32x4 ngw[4], nvw[4];
#pragma unroll
            for (int q = 0; q < 4; ++q) {
                const int t = t0 + q + 1;
                if (t < 32) { const bf16_t* np = A + (size_t)(rs + t) * F2 + c; ngw[q] = *(const u32x4*)np; nvw[q] = *(const u32x4*)(np + FH); }
                else if (seg_end) { ngw[q] = (u32x4){0u, 0u, 0u, 0u}; nvw[q] = ngw[q]; }
                else { const bf16_t* hp = HL + (size_t)((rg + 1) * 2) * F2 + c; ngw[q] = *(const u32x4*)hp; nvw[q] = *(const u32x4*)(hp + FH); }
            }
#pragma unroll
            for (int q = 0; q < 4; ++q) {
                float pg[8], pv[8], cg_[8], cv[8], ng[8], nv[8];
                unpack8(pgw, pg); unpack8(pvw, pv); unpack8(cgw, cg_); unpack8(cvw, cv); unpack8(ngw[q], ng); unpack8(nvw[q], nv);
                float o[8];
#pragma unroll
                for (int e = 0; e < 8; ++e) { const float gg = bg[e] + w0g[e] * pg[e] + w1g[e] * cg_[e] + w2g[e] * ng[e]; const float vv = bv[e] + w0v[e] * pv[e] + w1v[e] * cv[e] + w2v[e] * nv[e];
                    o[e] = siluf_(gg) * vv; }
                u32x4 ow; ow.x = pk2(o[0], o[1]); ow.y = pk2(o[2], o[3]); ow.z = pk2(o[4], o[5]); ow.w = pk2(o[6], o[7]);
                if (dry) *(u32x4*)(HBd + ((size_t)(rs + t0 + q) * F2 + c) % ((size_t)33 * 1024 * 1024 - 8)) = ow; else *(u32x4*)(A + (size_t)(rs + t0 + q) * F2 + c) = ow;
                pgw = cgw; pvw = cvw; cgw = ngw[q]; cvw = nvw[q];
            }
        }
    }
}

__device__ __forceinline__ void final_norm(const KArgs& a, int gw, int ngw, int lane) {
    const float* g = ain(a, 25);
    for (int r = gw; r < NB * SEQ; r += ngw) {
        float* row = outp(a) + (size_t)r * D;
        f32x4 v[4]; float ss = 0.f;
#pragma unroll
        for (int j = 0; j < 4; ++j) { v[j] = *(const f32x4*)(row + (lane + 64 * j) * 4); ss += (v[j][0] * v[j][0] + v[j][1] * v[j][1]) + (v[j][2] * v[j][2] + v[j][3] * v[j][3]); }
        const float rstd = __builtin_amdgcn_rsqf(wave_sum(ss) * (1.0f / D) + EPS);
#pragma unroll
        for (int j = 0; j < 4; ++j) { const f32x4 gv = *(const f32x4*)(g + (lane + 64 * j) * 4); *(f32x4*)(row + (lane + 64 * j) * 4) = v[j] * rstd * gv; }
    }
}

#define LAS __attribute__((address_space(3)))
#define XB_TMO      128
#define XB_XCNT(j)  (256  + 64 * (j))
#define XB_XSUB(j)  (1280 + 64 * (j))
#define XB_XGEN(j)  (2304 + 64 * (j))
#define XB_TOP      3328
#define XB_TOPGEN   3392
#define XCD_BAR_WORDS 3456
#define XB_SPIN_CAP (1u << 18)

__device__ __forceinline__ unsigned xb_ld(unsigned* p)              { return __hip_atomic_load(p, __ATOMIC_RELAXED, __HIP_MEMORY_SCOPE_AGENT); }
__device__ __forceinline__ unsigned xb_add(unsigned* p, unsigned v) { return __hip_atomic_fetch_add(p, v, __ATOMIC_RELAXED, __HIP_MEMORY_SCOPE_AGENT); }
__device__ __forceinline__ unsigned xb_xcc_id() { return (unsigned)__builtin_amdgcn_s_getreg((3 << 11) | 20) & 0xFu; }
#define XB_SPIN(cond, bar) do { unsigned _sp = 0; while (cond) { __builtin_amdgcn_s_sleep(1); \
    if ((++_sp & 255u) == 0u) { if (xb_ld(&(bar)[XB_TMO])) break; if (_sp > XB_SPIN_CAP) { atomicAdd(&(bar)[XB_TMO], 1u); break; } } } } while (0)

struct XcdBarrier {
    unsigned* bar; unsigned x;
    volatile LAS unsigned* st;
};

__device__ __forceinline__ XcdBarrier xcd_barrier_post(unsigned* bar, volatile LAS unsigned* st) {
    XcdBarrier b; b.bar = bar; b.x = xb_xcc_id(); b.st = st;
    if (threadIdx.x == 0) (void)xb_add(&bar[XB_XCNT(b.x)], 1u);
    return b;
}
__device__ __forceinline__ void xcd_barrier_complete(unsigned* bar, unsigned x, unsigned& nloc, unsigned& nx) {
    const unsigned G = gridDim.x * gridDim.y * gridDim.z;
    unsigned sum, cnt, mine, sp = 0u;
    for (;;) {
        sum = 0u; cnt = 0u; mine = 0u;
#pragma unroll
        for (unsigned j = 0; j < 16; ++j) { const unsigned c = xb_ld(&bar[XB_XCNT(j)]); sum += c; cnt += (c > 0u) ? 1u : 0u; mine = (j == x) ? c : mine; }
        if (sum == G) break;
        __builtin_amdgcn_s_sleep(1);
        if ((++sp & 255u) == 0u) { if (xb_ld(&bar[XB_TMO])) break; if (sp > XB_SPIN_CAP) { atomicAdd(&bar[XB_TMO], 1u); break; } }
    }
    nloc = mine > 0u ? mine : 1u; nx = cnt > 0u ? cnt : 1u;
}

__device__ __forceinline__ void xcd_barrier(const XcdBarrier& b) {
    asm volatile("s_waitcnt vmcnt(0)" ::: "memory");
    __syncthreads();
    if (threadIdx.x == 0) {
        unsigned* bar = b.bar;
        __builtin_amdgcn_s_waitcnt(0);
        unsigned nloc = b.st[0], nx = b.st[1];
        if (nloc == 0u) { xcd_barrier_complete(bar, b.x, nloc, nx); b.st[0] = nloc; b.st[1] = nx; }
        const unsigned old = xb_add(&bar[XB_XSUB(b.x)], 1u);
        const unsigned gen = old / nloc;
        if (old + 1u == (gen + 1u) * nloc) {
            __builtin_amdgcn_fence(__ATOMIC_RELEASE, "agent");
            asm volatile("s_waitcnt vmcnt(0)" ::: "memory");
            const unsigned og = xb_add(&bar[XB_TOP], 1u);
            const unsigned tg = og / nx;
            if (og + 1u == (tg + 1u) * nx) xb_add(&bar[XB_TOPGEN], 1u);
            else XB_SPIN(xb_ld(&bar[XB_TOPGEN]) == tg, bar);
            __builtin_amdgcn_fence(__ATOMIC_ACQUIRE, "agent");
            xb_add(&bar[XB_XGEN(b.x)], 1u);
            asm volatile("s_waitcnt vmcnt(0)" ::: "memory");
        } else {
            XB_SPIN(xb_ld(&bar[XB_XGEN(b.x)]) == gen, bar);
            __builtin_amdgcn_fence(__ATOMIC_ACQUIRE, "agent");
            asm volatile("s_waitcnt vmcnt(0)" ::: "memory");
        }
    }
    __syncthreads();
}

#ifndef PHASEMASK
#define PHASEMASK 0xffffffffu
#endif
#define PH(k) (((PHASEMASK) >> (k)) & 1u)
#ifndef REPMASK
#define REPMASK 0u
#endif
#define NREP(k) ((((REPMASK) >> (k)) & 1u) ? 2 : 1)
__device__ __forceinline__ int q_next(unsigned* ctr, volatile int* slot) { __syncthreads(); if (threadIdx.x == 0) *slot = (int)atomicAdd(ctr, 1u); __syncthreads(); return __builtin_amdgcn_readfirstlane(*slot); }

__global__ void __launch_bounds__(NTHR, 2) fwd_megakernel(KArgs a) {
    extern __shared__ __attribute__((aligned(16))) unsigned char lds[];
    cg::grid_group grid = cg::this_grid();
    const int G = gridDim.x, ngw = G * NWV;
#define TLW() const int tid = opaque((int)threadIdx.x), lane = tid & 63, wave = __builtin_amdgcn_readfirstlane(tid >> 6), gw = blockIdx.x * NWV + wave; (void)lane; (void)gw
    unsigned* ctl = (unsigned*)(wsp(a) + WS_CTL);
    volatile int* slot = (volatile int*)(lds + LDS_SLOT);
    LASP unsigned char* lds3 = (LASP unsigned char*)lds;
    typedef pg8::StaticOrder SO; typedef pg8::RowOrder RO;
    { volatile LAS unsigned* st0 = (volatile LAS unsigned*)(lds3 + LDS_SLOT + 16); if (threadIdx.x < 2) st0[threadIdx.x] = 0u; }
    __syncthreads();
    const XcdBarrier xbar = xcd_barrier_post(ctl + 4096, (volatile LAS unsigned*)(lds3 + LDS_SLOT + 16));

    if constexpr (PH(0)) { TLW(); convert_weights(a, 0, (char*)lds, gw, ngw, wave, lane);
    __syncthreads();
    mods_phase(a, (char*)lds, tid); }
    if (a.ws == nullptr) grid.sync();
    xcd_barrier(xbar);

    for (int l = 0; l < 2; ++l) {
        const XPtrs X = xptrs(a, l);
        const float* MODl = (const float*)(wsp(a) + WS_MOD) + (size_t)l * 5 * 6144;
        if constexpr (PH(1)) for (int rp = 0; rp < NREP(8); ++rp) { TLW(); norm_phase(a, l, 1, X.in_lat, X.in_ctx, gw, ngw, lane); }
        if (PH(0) && l == 1) { TLW(); __syncthreads(); convert_weights(a, 1, (char*)lds, gw, ngw, wave, lane); }
        xcd_barrier(xbar);
        if constexpr (PH(2)) for (int rp = 0; rp < NREP(0); ++rp) { pg8::Gemm g{(const bf16_t*)(wsp(a) + WS_HB), (const bf16_t*)(wsp(a) + W_MIX), M, PMW, D, D}; RO S; S.init(PMW, G, (int)blockIdx.x, 0);
          pg8::EpiStore<0, false> E{(bf16_t*)(wsp(a) + WS_PM), PMW, nullptr};
          pg8::gemm_phase<pg8::EpiStore<0, false>, RO, true, true>(lds3, g, S, E); }
        xcd_barrier(xbar);
        if constexpr (PH(3)) { TLW(); if (NREP(12) > 1) qk_phase(a, l, gw, ngw, lane, true); qk_phase(a, l, gw, ngw, lane, false); }
        __syncthreads();
        if constexpr (PH(4)) { TLW(); unsigned* ctrA = ctl + 64 * (3 + l);
            for (;;) { int u = q_next(ctrA, slot); if (u >= GLA_UNITS_A * NREP(1)) break; u %= GLA_UNITS_A;
                const int sc = 16 - (u / 32), bhd = u % 32;
                if (((bhd & 1) == 0 && sc == 16) || ((bhd & 1) == 1 && sc == 1)) continue;
                gla_unit_a(a, l, bhd * GLA_NSC + sc, (char*)lds, tid, lane, wave); } }
        xcd_barrier(xbar);
        {
            unsigned* ctr = ctl + 64 * (1 + l);
            const attn_body::bf16* PMa = (const attn_body::bf16*)(wsp(a) + WS_PM); attn_body::bf16* Ya = (attn_body::bf16*)(wsp(a) + WS_Y);
            for (;;) {
                int u = q_next(ctr, slot);
                if (u < NB * 4 * GLA_NSC * NREP(3)) { u %= NB * 4 * GLA_NSC; const int sc = 16 - (u / 16), bh = u % 16; const int unit = bh * GLA_NSC + sc;
                    if (l == 1 && sc == 0) continue;
                    if constexpr (PH(6)) { TLW(); gla_unit_c(a, l, unit, (char*)lds, tid, lane, wave); } continue; }
                u -= NB * 4 * GLA_NSC * NREP(3);
                if (u < 1024 * NREP(2)) { u &= 1023; if constexpr (PH(5)) { const int b = u >> 8, hk = (u >> 7) & 1, qb = (u & 127) >> 2, h = hk * 4 + (u & 3);
                    const size_t qrow = (size_t)b * TB + CTX + (size_t)qb * 256;
                    attn_body::attn_unit<8>(PMa + qrow * PMW + C_Q + h * 64, PMa + (size_t)b * TB * PMW + C_K + hk * 64, PMa + (size_t)b * TB * PMW + C_VV + hk * 64, Ya + qrow * YW + 512 + h * 64, 132, (char*)lds); }
                    continue; }
                u -= 1024 * NREP(2);
                if (u < 32) { if (l == 1) continue; if constexpr (PH(5)) { const int b = u >> 3, h = u & 7, hk = h >> 2; const size_t qrow = (size_t)b * TB;
                    attn_body::attn_unit<8>(PMa + qrow * PMW + C_Q + h * 64, PMa + qrow * PMW + C_K + hk * 64, PMa + qrow * PMW + C_VV + hk * 64, Ya + qrow * YW + 512 + h * 64, 4, (char*)lds); }
                    continue; }
                u -= 32;
                if (u < NB * 66 * 4 * NREP(4)) { u %= NB * 66 * 4; if (l == 1 && ((u >> 2) % 66) < 2) continue; if constexpr (PH(7)) { TLW(); gmlp_unit(a, l, u, (char*)lds, tid, lane, wave); } continue; }
                break;
            }
        }
        xcd_barrier(xbar);
        for (int gi = 0; gi < (l == 0 ? 1 : 3); ++gi) {
          const int npass = l == 0 ? NGATE : D;
          pg8::Gemm g{(const bf16_t*)(wsp(a) + WS_HB), (const bf16_t*)(wsp(a) + W_GATE) + (size_t)gi * D * D, M, npass, D, D}; RO S; S.init(npass, G, (int)blockIdx.x, l);
          pg8::EpiStore<2, false> E{(bf16_t*)(wsp(a) + WS_G) + gi * D, NGATE, nullptr};
          pg8::gemm_phase<pg8::EpiStore<2, false>, RO, true, true>(lds3, g, S, E); }
        if (l == 0) xcd_barrier(xbar);
        if constexpr (PH(9)) for (int bq = 0; bq < 3 * NREP(6); ++bq) { const int bi = bq % 3;
            pg8::Gemm g{(const bf16_t*)(wsp(a) + WS_Y) + bi * 512, (const bf16_t*)(wsp(a) + W_BR) + (size_t)bi * D * 512, M, D, 512, YW}; RO S; S.init(D, G, (int)blockIdx.x, l);
            pg8::EpiBranch E{(bf16_t*)(wsp(a) + WS_HB), (const bf16_t*)(wsp(a) + WS_G) + bi * D, bi == 0 ? 1 : 0};
            pg8::gemm_phase<pg8::EpiBranch, RO, true, true>(lds3, g, S, E);
        }
        xcd_barrier(xbar);
        if constexpr (PH(10)) { pg8::Gemm g{(const bf16_t*)(wsp(a) + WS_HB), (const bf16_t*)(wsp(a) + W_OUT), M, D, D, D}; RO S; S.init(D, G, (int)blockIdx.x, l);
          pg8::EpiResid E{X, MODl, 2, nullptr};
          pg8::gemm_phase<pg8::EpiResid, RO, true, true>(lds3, g, S, E);
          if (NREP(10) > 1) { XPtrs X2 = X; X2.in_lat = X.out_lat; X2.in_ctx = X.out_ctx; pg8::EpiResid E2{X2, MODl, 2, (const float*)(wsp(a) + 32768)}; pg8::gemm_phase<pg8::EpiResid, RO, true, true>(lds3, g, S, E2); } }
        xcd_barrier(xbar);
        if constexpr (PH(1)) for (int rp = 0; rp < NREP(8); ++rp) { TLW(); norm_phase(a, l, 2, X.out_lat, X.out_ctx, gw, ngw, lane); }
        xcd_barrier(xbar);
        if constexpr (PH(11)) for (int rp = 0; rp < NREP(7); ++rp) { pg8::Gemm g{(const bf16_t*)(wsp(a) + WS_HB), (const bf16_t*)(wsp(a) + W_UP), M, F2, D, D}; RO S; S.init(F2, G, (int)blockIdx.x, l);
          pg8::EpiStore<0, true> E{(bf16_t*)(wsp(a) + WS_A), F2, (bf16_t*)(wsp(a) + WS_HALO)};
          pg8::gemm_phase<pg8::EpiStore<0, true>, RO, true, true>(lds3, g, S, E); }
        xcd_barrier(xbar);
        if constexpr (PH(12)) { TLW(); if (NREP(11) > 1) { conv_phase(a, l, blockIdx.x * NTHR + tid, G * NTHR, true); __syncthreads(); } conv_phase(a, l, blockIdx.x * NTHR + tid, G * NTHR, false); }
        xcd_barrier(xbar);
        if constexpr (PH(13)) { pg8::Gemm g{(const bf16_t*)(wsp(a) + WS_A), (const bf16_t*)(wsp(a) + W_DOWN), M, D, FH, F2}; RO S; S.init(D, G, (int)blockIdx.x, l);
          XPtrs X2 = X; X2.in_lat = X.out_lat; X2.in_ctx = X.out_ctx;
          pg8::EpiResid E{X2, MODl, 5, nullptr};
          pg8::gemm_phase<pg8::EpiResid, RO, true, true>(lds3, g, S, E);
          if (NREP(10) > 1) { pg8::EpiResid E2{X2, MODl, 5, (const float*)(wsp(a) + 32768)}; pg8::gemm_phase<pg8::EpiResid, RO, true, true>(lds3, g, S, E2); } }
        xcd_barrier(xbar);
    }
#ifdef XSYNC
    for (int q = 0; q < XSYNC; ++q) xcd_barrier(xbar);
#endif
    { TLW(); final_norm(a, gw, ngw, lane); }
}

extern "C" void kernel_launch(void* const* d_in, const int* in_sizes, int n_in, void* d_out, int out_size, void* d_ws, size_t ws_size, hipStream_t stream) {
    static int grid_blocks = 0;
    if (grid_blocks == 0) {
        if (n_in != 26 || ws_size < WS_END) { fprintf(stderr, "kernel_launch: unexpected n_in %d / ws_size %zu\n", n_in, ws_size); grid_blocks = -1; return; }
        int dev = 0, cus = 0, per_cu = 0;
        hipGetDevice(&dev); hipDeviceGetAttribute(&cus, hipDeviceAttributeMultiprocessorCount, dev);
        if (hipFuncSetAttribute((const void*)fwd_megakernel, hipFuncAttributeMaxDynamicSharedMemorySize, LDS_BYTES) != hipSuccess) { fprintf(stderr, "kernel_launch: hipFuncSetAttribute failed\n"); }
        if (hipOccupancyMaxActiveBlocksPerMultiprocessor(&per_cu, (const void*)fwd_megakernel, NTHR, LDS_BYTES) != hipSuccess || per_cu < 1) { fprintf(stderr, "kernel_launch: occupancy query says %d\n", per_cu); per_cu = 1; }
        (void)hipGetLastError();
        grid_blocks = cus * 1;
    }
    if (grid_blocks < 0) return;
    hipMemsetAsync((char*)d_ws + WS_CTL, 0, 65536, stream);
    KArgs a{};
    for (int i = 0; i < 26; ++i) a.in[i] = (const float*)d_in[i];
    a.out = (float*)d_out; a.ws = (unsigned char*)d_ws;
    void* args[] = {&a};
    hipError_t e = hipLaunchCooperativeKernel((const void*)fwd_megakernel, dim3(grid_blocks), dim3(NTHR), args, LDS_BYTES, stream);
    if (e != hipSuccess) fprintf(stderr, "cooperative launch failed: %s (grid %d)\n", hipGetErrorString(e), grid_blocks);
}
```

```cpp
#include <hip/hip_runtime.h>
#include <hip/hip_cooperative_groups.h>
#include <cstdio>
#include <cstdint>
namespace cg = cooperative_groups;
namespace pg8 {
#define PG8_LAS __attribute__((address_space(3)))
typedef unsigned short bf16_t;
typedef short bf16x8 __attribute__((ext_vector_type(8)));
typedef float f32x4 __attribute__((ext_vector_type(4)));
typedef unsigned u32x4 __attribute__((ext_vector_type(4)));
constexpr int BM = 256, BK = 64, HALF = 128, HTB = HALF * BK * 2  , STAGE_BYTES = 8 * HTB, NXCD = 8, WGM = 8;

__host__ __device__ __forceinline__ int lds_byte(int r, int c) { const int st = (r >> 4) * 2 + (c >> 5), rr = r & 15, cc = c & 31, ob = rr * 64 + cc * 2; return st * 1024 + (ob ^ (((ob >> 9) & 1) << 5)); }
__host__ __device__ __forceinline__ void stage_rc(int b, int& R, int& C) { const int st = b / 1024, sb = b % 1024, swz = sb ^ (((sb >> 9) & 1) << 5); R = (st >> 1) * 16 + swz / 64; C = (st & 1) * 32 + (swz % 64) / 2; }
__host__ __device__ __forceinline__ int perm32(int rho) { const int n = rho >> 4, i = rho & 15; return 8 * (i >> 2) + 4 * n + (i & 3); }

struct Unit { int pm, pn; };
struct Gemm { const bf16_t* A; const bf16_t* Bt; int M, N, K, lda; };

struct StaticOrder {
    int nM, nN, nwg, G, c;
    __host__ __device__ void init(int M, int N, int G_, int c_) { nM = M / BM; nN = N / BM; nwg = nM * nN; G = G_; c = c_; }
    __host__ __device__ bool next(int i, Unit& u) const {
        const long L = (long)i * G + c; if (L >= nwg) return false;
        int wgid = (int)L; { const int q = nwg / NXCD, r = nwg % NXCD, xcd = wgid % NXCD, off = wgid / NXCD; wgid = (xcd < r ? xcd * (q + 1) : r * (q + 1) + (xcd - r) * q) + off; }
        const int nig = WGM * nN, gid = wgid / nig, fm = gid * WGM, gsz = (nM - fm) < WGM ? (nM - fm) : WGM;
        u.pm = fm + ((wgid % nig) % gsz); u.pn = (wgid % nig) / gsz; return true;
    }
    __device__ __forceinline__ void a_ready(const Unit&) const {}
    __device__ __forceinline__ void done(const Unit&) const {}
};

__device__ __forceinline__ unsigned cvt_pk_bf16(float lo, float hi) { unsigned r; asm volatile("v_cvt_pk_bf16_f32 %0, %1, %2" : "=v"(r) : "v"(lo), "v"(hi)); return r; }
typedef float f32x2 __attribute__((ext_vector_type(2)));
__device__ __forceinline__ f32x2 gelu_pk(f32x2 v) {
    const f32x2 av = __builtin_elementwise_abs(v), d = av * 0.2316418882f + 1.0f;
    f32x2 t; t.x = __builtin_amdgcn_rcpf(d.x); t.y = __builtin_amdgcn_rcpf(d.y);
    f32x2 q = t * 0.5307027145f + (-0.7265760135f); q = q * t + 0.7107068705f; q = q * t + (-0.142248368f); q = q * t + 0.127414796f; q = q * t;
    const f32x2 s = (v * v) * (-0.72134752044f);
    f32x2 e; e.x = __builtin_amdgcn_exp2f(s.x); e.y = __builtin_amdgcn_exp2f(s.y);
    const f32x2 m = v * (q * e), r = v - m;
    f32x2 o; o.x = v.x < 0.f ? m.x : r.x; o.y = v.y < 0.f ? m.y : r.y; return o;
}


template <class Epi, class Sched, bool ALIGN_EPI = false, bool SP2 = false>
__device__ __forceinline__ void gemm_phase(PG8_LAS unsigned char* lds, const Gemm g, const Sched& S, const Epi& E) {
    int tid = threadIdx.x; asm volatile("" : "+v"(tid)); const int wid = __builtin_amdgcn_readfirstlane(tid >> 6), lane = tid & 63, wr = wid >> 2, wc = wid & 3, fr = lane & 15, fq = lane >> 4;
    const int K = g.K, nt = K / BK;
    unsigned voffA[2], voffB[2];
#pragma unroll
    for (int i = 0; i < 2; ++i) { int R, C; stage_rc(tid * 16 + i * 8192, R, C); const int Rb = Epi::PERM ? ((R & ~31) + perm32(R & 31)) : R;
        voffA[i] = (unsigned)(R * g.lda + C) * 2u; voffB[i] = (unsigned)(Rb * K + C) * 2u; }
    const size_t kstep = (size_t)(BK * 2);
    const size_t hstepA = (size_t)HALF * g.lda * 2, hstepB = (size_t)HALF * K * 2;
    const size_t tstepA = 2 * hstepA, tstepB = 2 * hstepB;
    const unsigned ldsw = (unsigned)wid * 1024u;
    const int aoff = lds_byte(wr * 64 + fr, fq * 8), boff = lds_byte(wc * 32 + fr, fq * 8);
#define PG8_SA(b, h) (((b) * 2 + (h)) * HTB)
#define PG8_SB(b, h) ((4 + (b) * 2 + (h)) * HTB)
#define PG8_STAGE(bufoff, gbase, voff) do { _Pragma("unroll") for (int _i = 0; _i < 2; ++_i) \
        __builtin_amdgcn_global_load_lds((const unsigned*)((const char*)(gbase) + (voff)[_i]), (PG8_LAS unsigned*)(lds + (bufoff) + ldsw + _i * 8192), 16, 0, 0); } while (0)
#define PG8_LDA(dst, b, h) do { _Pragma("unroll") for (int m = 0; m < 4; ++m) _Pragma("unroll") for (int k = 0; k < 2; ++k) dst[m][k] = *(const PG8_LAS bf16x8*)(lds + PG8_SA(b, h) + aoff + m * 2048 + k * 1024); } while (0)
#define PG8_LDB(dst, b, h) do { _Pragma("unroll") for (int n = 0; n < 2; ++n) _Pragma("unroll") for (int k = 0; k < 2; ++k) dst[n][k] = *(const PG8_LAS bf16x8*)(lds + PG8_SB(b, h) + boff + n * 2048 + k * 1024); } while (0)
#define PG8_MMA(ai, bj, At, Bt) do { __builtin_amdgcn_s_setprio(1); _Pragma("unroll") for (int m = 0; m < 4; ++m) _Pragma("unroll") for (int n = 0; n < 2; ++n) _Pragma("unroll") for (int k = 0; k < 2; ++k) \
        acc[ai][bj][m][n] = __builtin_amdgcn_mfma_f32_16x16x32_bf16(Bt[n][k], At[m][k], acc[ai][bj][m][n], 0, 0, 0); __builtin_amdgcn_s_setprio(0); } while (0)
#define PG8_WAIT_V(n) asm volatile("s_waitcnt vmcnt(" #n ")" ::: "memory")
#define PG8_WAIT_L(n) asm volatile("s_waitcnt lgkmcnt(" #n ")" ::: "memory")
#define PG8_BAR __builtin_amdgcn_s_barrier()
#define PG8_SCHED __builtin_amdgcn_sched_barrier(0)
    Unit cur, nxt; int ui = 0;
    if (!S.next(0, cur)) return;
    f32x4 acc[2][2][4][2];
#pragma unroll
    for (int a = 0; a < 2; ++a)
#pragma unroll
        for (int b = 0; b < 2; ++b)
#pragma unroll
            for (int m = 0; m < 4; ++m)
#pragma unroll
                for (int n = 0; n < 2; ++n) acc[a][b][m][n] = (f32x4){0.f, 0.f, 0.f, 0.f};
    bf16x8 At[4][2], B0[2][2], B1[2][2];
    const char* cA = (const char*)g.A + (size_t)cur.pm * tstepA; const char* cB = (const char*)g.Bt + (size_t)cur.pn * tstepB;
    S.a_ready(cur);
    if constexpr (SP2) {
        PG8_STAGE(PG8_SB(0, 0), cB, voffB); PG8_STAGE(PG8_SB(0, 1), cB + hstepB, voffB); PG8_STAGE(PG8_SA(0, 0), cA, voffA); PG8_STAGE(PG8_SA(0, 1), cA + hstepA, voffA);
        if (wr == 1) PG8_BAR;
        PG8_WAIT_V(2); PG8_BAR;
        PG8_STAGE(PG8_SB(1, 0), cB + kstep, voffB); PG8_STAGE(PG8_SA(1, 0), cA + kstep, voffA); PG8_STAGE(PG8_SB(1, 1), cB + hstepB + kstep, voffB);
        PG8_WAIT_V(6); PG8_BAR;
    } else {
        PG8_STAGE(PG8_SB(0, 0), cB, voffB); PG8_STAGE(PG8_SA(0, 0), cA, voffA); PG8_STAGE(PG8_SB(0, 1), cB + hstepB, voffB); PG8_STAGE(PG8_SA(0, 1), cA + hstepA, voffA);
        if (wr == 1) PG8_BAR;
        PG8_WAIT_V(4); PG8_BAR;
        PG8_STAGE(PG8_SB(1, 0), cB + kstep, voffB); PG8_STAGE(PG8_SA(1, 0), cA + kstep, voffA); PG8_STAGE(PG8_SB(1, 1), cB + hstepB + kstep, voffB);
        PG8_WAIT_V(6); PG8_BAR;
    }
    for (;;) {
        const bool has_next = S.next(ui + 1, nxt);
        const char* nA = has_next ? (const char*)g.A + (size_t)nxt.pm * tstepA : cA; const char* nB = has_next ? (const char*)g.Bt + (size_t)nxt.pn * tstepB : cB;
        for (int t = 0; t < nt; t += 2) {
            const bool last = (t == nt - 2);
            const char* a1 = cA + (size_t)(t + 1) * kstep;
            const char* a2 = last ? nA : cA + (size_t)(t + 2) * kstep; const char* b2 = last ? nB : cB + (size_t)(t + 2) * kstep;
            const char* a3 = a2 + kstep; const char* b3 = b2 + kstep;
            if (last && has_next) S.a_ready(nxt);
            if constexpr (SP2) {
            PG8_LDB(B0, 0, 0); PG8_LDB(B1, 0, 1); PG8_SCHED; PG8_LDA(At, 0, 0); PG8_STAGE(PG8_SA(1, 1), a1 + hstepA, voffA);
            PG8_WAIT_V(8); PG8_WAIT_L(0); PG8_BAR; PG8_MMA(0, 0, At, B0); PG8_MMA(0, 1, At, B1); PG8_BAR; PG8_SCHED;
            PG8_LDA(At, 0, 1); PG8_STAGE(PG8_SB(0, 0), b2, voffB); PG8_STAGE(PG8_SB(0, 1), b2 + hstepB, voffB); PG8_STAGE(PG8_SA(0, 0), a2, voffA);
            PG8_WAIT_V(8); PG8_WAIT_L(0); PG8_BAR; PG8_MMA(1, 0, At, B0); PG8_MMA(1, 1, At, B1); PG8_BAR; PG8_SCHED;
            PG8_LDB(B0, 1, 0); PG8_LDB(B1, 1, 1); PG8_SCHED; PG8_LDA(At, 1, 0); PG8_STAGE(PG8_SA(0, 1), a2 + hstepA, voffA);
            PG8_WAIT_V(8); PG8_WAIT_L(0); PG8_BAR; PG8_MMA(0, 0, At, B0); PG8_MMA(0, 1, At, B1); PG8_BAR; PG8_SCHED;
            PG8_LDA(At, 1, 1); PG8_STAGE(PG8_SB(1, 0), b3, voffB); PG8_STAGE(PG8_SB(1, 1), b3 + hstepB, voffB); PG8_STAGE(PG8_SA(1, 0), a3, voffA);
            PG8_WAIT_V(8); PG8_WAIT_L(0); PG8_BAR; PG8_MMA(1, 0, At, B0); PG8_MMA(1, 1, At, B1); PG8_BAR; PG8_SCHED;
            } else {
            PG8_LDB(B0, 0, 0); PG8_SCHED; PG8_LDA(At, 0, 0); PG8_STAGE(PG8_SA(1, 1), a1 + hstepA, voffA);
            PG8_WAIT_L(8); PG8_BAR; PG8_WAIT_L(0); PG8_MMA(0, 0, At, B0); PG8_BAR; PG8_SCHED;
            PG8_LDB(B1, 0, 1); PG8_STAGE(PG8_SB(0, 0), b2, voffB);
            PG8_BAR; PG8_WAIT_L(0); PG8_MMA(0, 1, At, B1); PG8_BAR;
            PG8_LDA(At, 0, 1); PG8_STAGE(PG8_SA(0, 0), a2, voffA);
            PG8_BAR; PG8_WAIT_L(0); PG8_MMA(1, 0, At, B0); PG8_BAR; PG8_SCHED;
            PG8_STAGE(PG8_SB(0, 1), b2 + hstepB, voffB);
            PG8_WAIT_V(6); PG8_BAR; PG8_MMA(1, 1, At, B1); PG8_BAR;
            PG8_LDB(B0, 1, 0); PG8_SCHED; PG8_LDA(At, 1, 0); PG8_STAGE(PG8_SA(0, 1), a2 + hstepA, voffA);
            PG8_WAIT_L(8); PG8_BAR; PG8_WAIT_L(0); PG8_MMA(0, 0, At, B0); PG8_BAR; PG8_SCHED;
            PG8_LDB(B1, 1, 1); PG8_STAGE(PG8_SB(1, 0), b3, voffB);
            PG8_BAR; PG8_WAIT_L(0); PG8_MMA(0, 1, At, B1); PG8_BAR;
            PG8_LDA(At, 1, 1); PG8_STAGE(PG8_SA(1, 0), a3, voffA);
            PG8_BAR; PG8_WAIT_L(0); PG8_MMA(1, 0, At, B0); PG8_BAR; PG8_SCHED;
            PG8_STAGE(PG8_SB(1, 1), b3 + hstepB, voffB);
            PG8_WAIT_V(6); PG8_BAR; PG8_MMA(1, 1, At, B1); PG8_BAR;
            }
        }
        if constexpr (ALIGN_EPI) { if (wr == 0) PG8_BAR; }
        if constexpr (!Epi::AFTER_DRAIN) { E(acc, cur, wr, wc, fr, fq); S.done(cur); }
        if (!has_next) break;
#pragma unroll
        for (int a = 0; a < 2; ++a)
#pragma unroll
            for (int b = 0; b < 2; ++b)
#pragma unroll
                for (int m = 0; m < 4; ++m)
#pragma unroll
                    for (int n = 0; n < 2; ++n) acc[a][b][m][n] = (f32x4){0.f, 0.f, 0.f, 0.f};
        cur = nxt; cA = nA; cB = nB; ++ui;
        if constexpr (ALIGN_EPI) { if (wr == 1) PG8_BAR; }
    }
    PG8_WAIT_V(0);
    if constexpr (!ALIGN_EPI) { if (wr == 0) PG8_BAR; }
    PG8_BAR;
    if constexpr (Epi::AFTER_DRAIN) { E.fused(acc, cur, wr, wc, fr, fq, lds, wid, lane); S.done(cur); }
#undef PG8_SA
#undef PG8_SB
#undef PG8_STAGE
#undef PG8_LDA
#undef PG8_LDB
#undef PG8_MMA
#undef PG8_WAIT_V
#undef PG8_WAIT_L
#undef PG8_BAR
#undef PG8_SCHED
}
}
#include <hip/hip_bf16.h>
#include <cmath>
namespace attn_body {
using bf16=__hip_bfloat16;
using bf16x8=__attribute__((ext_vector_type(8)))short;
using s16x4=__attribute__((ext_vector_type(4)))short;
using f32x16=__attribute__((ext_vector_type(16)))float;
using u32x4=__attribute__((ext_vector_type(4)))unsigned;
constexpr int D=64;
constexpr int PQ=3584, PKV=3584, PO=1536;
constexpr int NW=8,QBLK=32,QB=QBLK*NW,KVBLK=64;
__device__ __forceinline__ int crow(int r,int hi){return (r&3)+8*(r>>2)+4*hi;}
#define SBAR() __builtin_amdgcn_sched_barrier(0)
constexpr int NSLOT=3, SLOTB=8192;
constexpr int LDS_K=0, LDS_V=NSLOT*SLOTB, LDS_WS=2*NSLOT*SLOTB, LDS_OST=LDS_WS+NW*64*4, LDS_BYTES=LDS_OST+NW*4096;
constexpr float C2=0.125f*1.4426950408889634f;
__device__ __forceinline__ void glds16(const void*gsrc,unsigned lds_dst){unsigned keep;
  asm volatile("s_mov_b32 %0, m0\n\ts_mov_b32 m0, %2\n\ts_nop 0\n\tglobal_load_lds_dwordx4 %1, off\n\ts_mov_b32 m0, %0":"=&s"(keep):"v"(gsrc),"s"(lds_dst):"memory");}
__device__ __forceinline__ float max3f(float a,float b,float c){float r;asm("v_max3_f32 %0, %1, %2, %3":"=v"(r):"v"(a),"v"(b),"v"(c));return r;}
__device__ __forceinline__ float max2f(float a,float b){float r;asm("v_max_f32_e32 %0, %1, %2":"=v"(r):"v"(a),"v"(b));return r;}
__device__ __forceinline__ float fadd_s(float a,float b){float r;asm("v_add_f32_e32 %0, %1, %2":"=v"(r):"v"(a),"v"(b));return r;}
__device__ __forceinline__ float fsub_s(float a,float b){float r;asm("v_sub_f32_e32 %0, %1, %2":"=v"(r):"v"(a),"v"(b));return r;}
typedef float f32x2_t __attribute__((ext_vector_type(2))); typedef __bf16 bf16x2_t __attribute__((ext_vector_type(2)));
__device__ __forceinline__ unsigned cvtpk_s(float lo,float hi){f32x2_t v={lo,hi};bf16x2_t b=__builtin_convertvector(v,bf16x2_t);return __builtin_bit_cast(unsigned,b);}
#define WAIT_BAR(N) asm volatile("s_waitcnt vmcnt(" #N ") lgkmcnt(0)\n\ts_barrier":::"memory")

__device__ __forceinline__ void qkt(f32x16&p0,f32x16&p1,const char*Kslot,const bf16x8*qr,const f32x16&negm,int r32,int hi){
  const char*kb=Kslot+hi*1024+r32*16;
  #pragma unroll
  for(int d0=0;d0<4;++d0){
    const bf16x8 b0=*reinterpret_cast<const bf16x8*>(kb+d0*2048);
    const bf16x8 b1=*reinterpret_cast<const bf16x8*>(kb+d0*2048+512);
    if(d0==0){p0=__builtin_amdgcn_mfma_f32_32x32x16_bf16(b0,qr[0],negm,0,0,0);p1=__builtin_amdgcn_mfma_f32_32x32x16_bf16(b1,qr[0],negm,0,0,0);}
    else{p0=__builtin_amdgcn_mfma_f32_32x32x16_bf16(b0,qr[d0],p0,0,0,0);p1=__builtin_amdgcn_mfma_f32_32x32x16_bf16(b1,qr[d0],p1,0,0,0);}}
}
typedef __attribute__((address_space(3))) const char* lds_cptr;
typedef short v4i16_t __attribute__((ext_vector_type(4)));
__device__ __forceinline__ void kload8(bf16x8*kf,lds_cptr kp){
  kf[0]=*(const __attribute__((address_space(3))) bf16x8*)(kp);      kf[1]=*(const __attribute__((address_space(3))) bf16x8*)(kp+512);
  kf[2]=*(const __attribute__((address_space(3))) bf16x8*)(kp+2048); kf[3]=*(const __attribute__((address_space(3))) bf16x8*)(kp+2560);
  kf[4]=*(const __attribute__((address_space(3))) bf16x8*)(kp+4096); kf[5]=*(const __attribute__((address_space(3))) bf16x8*)(kp+4608);
  kf[6]=*(const __attribute__((address_space(3))) bf16x8*)(kp+6144); kf[7]=*(const __attribute__((address_space(3))) bf16x8*)(kp+6656);
}
__device__ __forceinline__ void kload2(bf16x8*kf,lds_cptr kp,int j){ kf[2*j]=*(const __attribute__((address_space(3))) bf16x8*)(kp+j*2048); kf[2*j+1]=*(const __attribute__((address_space(3))) bf16x8*)(kp+j*2048+512); }
__device__ __forceinline__ s16x4 vtr(lds_cptr p){ return __builtin_bit_cast(s16x4,__builtin_amdgcn_ds_read_tr16_b64_v4i16((__attribute__((address_space(3))) v4i16_t*)p)); }
__device__ __forceinline__ float rowmax(const f32x16&p0,const f32x16&p1){
  float a=max3f(p0[0],p0[1],p1[0]),b=max3f(p0[2],p0[3],p1[1]);a=max3f(a,p1[2],p1[3]);
  #pragma unroll
  for(int r=4;r<16;r+=4){a=max3f(a,p0[r],p0[r+1]);b=max3f(b,p0[r+2],p0[r+3]);a=max3f(a,p1[r],p1[r+1]);b=max3f(b,p1[r+2],p1[r+3]);}
  const float m=max2f(a,b);
  auto rr=__builtin_amdgcn_permlane32_swap(__float_as_uint(m),__float_as_uint(m),false,false);
  return max2f(__uint_as_float(rr[0]),__uint_as_float(rr[1]));
}
__device__ __forceinline__ void pv(f32x16*o,int vb,bf16x8 pa0,bf16x8 pa1,bf16x8 pa2,bf16x8 pa3){
  #pragma unroll
  for(int d0=0;d0<2;++d0){s16x4 lo[4],hi[4];
    #pragma unroll
    for(int ks=0;ks<4;++ks){
      asm volatile("ds_read_b64_tr_b16 %0,%1 offset:%c2":"=&v"(lo[ks]):"v"(vb),"i"(d0*4096+ks*1024):"memory");
      asm volatile("ds_read_b64_tr_b16 %0,%1 offset:%c2":"=&v"(hi[ks]):"v"(vb),"i"(d0*4096+ks*1024+512):"memory");}
    asm volatile("s_waitcnt lgkmcnt(0)":::"memory");SBAR();
    #define PK(k) (bf16x8){lo[k][0],lo[k][1],lo[k][2],lo[k][3],hi[k][0],hi[k][1],hi[k][2],hi[k][3]}
    o[d0]=__builtin_amdgcn_mfma_f32_32x32x16_bf16(pa0,PK(0),o[d0],0,0,0);
    o[d0]=__builtin_amdgcn_mfma_f32_32x32x16_bf16(pa1,PK(1),o[d0],0,0,0);
    o[d0]=__builtin_amdgcn_mfma_f32_32x32x16_bf16(pa2,PK(2),o[d0],0,0,0);
    o[d0]=__builtin_amdgcn_mfma_f32_32x32x16_bf16(pa3,PK(3),o[d0],0,0,0);
    #undef PK
  }
}

#ifndef ATTN_STORE16
#define ATTN_STORE16(p,v) (*(u32x4*)(p)=(v))
#endif
template<int THRL> __device__ __forceinline__ void attn_unit(const bf16*Qblk,const bf16*__restrict__ Kh,const bf16*__restrict__ Vh,bf16*Oblk,const int NT,char*shm){
  int tid=threadIdx.x; asm volatile("":"+v"(tid)); const int lane=tid&63,r32=lane&31,hi=lane>>5; const int wid=__builtin_amdgcn_readfirstlane(tid>>6);
  const bf16*Qw=Qblk+(long)(wid*QBLK)*PQ;
  const unsigned lds0=(unsigned)(uintptr_t)shm;
  float*wsf=(float*)(shm+LDS_WS)+wid*64;
  const bf16*ksrc=Kh+(long)lane*PKV+wid*8;
  const bf16*vsrc=Vh+(long)(16*(wid&3)+(lane>>2))*PKV+(wid>>2)*32+(lane&3)*8;
  const unsigned kdst=lds0+LDS_K+wid*1024, vdst=lds0+LDS_V+wid*1024;
  #define DMA_K(t,slot) glds16(ksrc+(long)(t)*KVBLK*PKV,(unsigned)__builtin_amdgcn_readfirstlane(kdst+(slot)))
  #define DMA_V(t,slot) glds16(vsrc+(long)(t)*KVBLK*PKV,(unsigned)__builtin_amdgcn_readfirstlane(vdst+(slot)))
  const int vb0=(int)(lds0+LDS_V)+((lane>>4)&1)*32+(lane&3)*8+(4*hi+((lane&15)>>2))*64;
  const char*Kbase=shm+LDS_K; bf16x8 kf[8];
  const lds_cptr shm3=(lds_cptr)shm; const lds_cptr kp0=shm3+LDS_K+hi*1024+r32*16; const lds_cptr vp0=shm3+LDS_V+((lane>>4)&1)*32+(lane&3)*8+(4*hi+((lane&15)>>2))*64;
  DMA_K(0,0);DMA_V(0,0);DMA_K(1,SLOTB);
  bf16x8 qr[4];
  #pragma unroll
  for(int d0=0;d0<4;++d0)qr[d0]=*reinterpret_cast<const bf16x8*>(&Qw[(long)r32*PQ+d0*16+hi*8]);
  float mhat=0.f,l_reg=0.f;f32x16 o[2];o[0]=f32x16{};o[1]=f32x16{};f32x16 negm=f32x16{};asm volatile("":"+v"(negm));
  #define CMASK(P0,P1,t) do{}while(0)
  bool resc=false;
  #define START(P0,P1) do{ const float rm=rowmax(P0,P1); resc=false; \
    { const float dl=rm; mhat=fadd_s(mhat,dl); \
      _Pragma("unroll") for(int r=0;r<16;++r){P0[r]=fsub_s(P0[r],dl);P1[r]=fsub_s(P1[r],dl);} \
      _Pragma("unroll") for(int r=0;r<16;++r)negm[r]=-mhat; asm volatile("":"+v"(negm)); } \
    _Pragma("unroll") for(int r=0;r<16;++r)P0[r]=__builtin_amdgcn_exp2f(P0[r]); }while(0)
  #define RESC() do{ if(resc){ asm volatile("s_waitcnt lgkmcnt(0)":::"memory"); \
      _Pragma("unroll") for(int d_=0;d_<2;++d_) _Pragma("unroll") for(int r=0;r<16;++r)o[d_][r]*=wsf[crow(r,hi)]; } }while(0)
  f32x16 pA0,pA1,pB0,pB1;
  int sl_prev=0,sl_cur=0,sl_next=SLOTB;
  #define ROT() do{sl_prev=sl_cur;sl_cur=sl_next;sl_next=(sl_next==(NSLOT-1)*SLOTB)?0:sl_next+SLOTB;}while(0)
  DMA_K(2,2*SLOTB);
  WAIT_BAR(3);
  qkt(pA0,pA1,Kbase,qr,negm,r32,hi);asm volatile("s_nop 15\n\ts_nop 7":"+v"(pA0),"+v"(pA1));CMASK(pA0,pA1,0);
  START(pA0,pA1);
  _Pragma("unroll") for(int r=0;r<16;++r)pA1[r]=__builtin_amdgcn_exp2f(pA1[r]);
  WAIT_BAR(0);
  DMA_K(3,0);DMA_V(1,SLOTB);
  ROT();
  kload8(kf,kp0+sl_cur);
  WAIT_BAR(2);
  s16x4 vlo[8],vhi[8]; u32x4 pw0,pw1,pw2,pw3;
  #define PKW(P,B) cvtpk_s(P[B],P[B+1])
  #define PAF(k) __builtin_bit_cast(bf16x8,pw##k)
  #define VFR(i) (bf16x8){vlo[i][0],vlo[i][1],vlo[i][2],vlo[i][3],vhi[i][0],vhi[i][1],vhi[i][2],vhi[i][3]}
  #define PIN(x) asm volatile("":"+v"(x))
  #define MX3(a,b,c) __builtin_fmaxf(__builtin_fmaxf((a),(b)),(c))
  #define GAPA(MF,A0,A1,A2,A3,W0,W1,PW) do{ MF; sacc+=A0; sacc+=A1; sacc+=A2; sacc+=A3; PIN(sacc); W0; W1; PIN(PW); SBAR(); }while(0)
  #define EX(v) __builtin_amdgcn_exp2f(v)
  #define GAPB(MF,X,B) do{ MF; X[B]=EX(X[B]); X[B+1]=EX(X[B+1]); X[B+2]=EX(X[B+2]); X[B+3]=EX(X[B+3]); PIN(X); SBAR(); }while(0)
  #define VRD(i) do{ vlo[i]=vtr(vp_+(((i)>>2)*4096+((i)&3)*1024)); vhi[i]=vtr(vp_+(((i)>>2)*4096+((i)&3)*1024+512)); }while(0)
  #define KRD(G,j) do{ if(G){ kload2(kf,kp0+sl_next,j); SBAR(); } }while(0)
  #define STEP(C0,C1,P0,P1,t,GK,GV,GL) do{ SBAR(); \
    const lds_cptr vp_=vp0+sl_prev; \
    VRD(0); SBAR(); float sacc=(P0[0]+P0[1]); \
    GAPA(C0=__builtin_amdgcn_mfma_f32_32x32x16_bf16(kf[0],qr[0],negm,0,0,0), P0[2],P0[3],P0[4],P0[5],     pw0[0]=PKW(P0,0), pw0[1]=PKW(P0,2), pw0); \
    VRD(4); SBAR(); GAPA(C1=__builtin_amdgcn_mfma_f32_32x32x16_bf16(kf[1],qr[0],negm,0,0,0), P0[6],P0[7],P0[8],P0[9],     pw0[2]=PKW(P0,4), pw0[3]=PKW(P0,6), pw0); \
    VRD(1); SBAR(); GAPA(C0=__builtin_amdgcn_mfma_f32_32x32x16_bf16(kf[2],qr[1],C0,0,0,0),   P0[10],P0[11],P0[12],P0[13], pw1[0]=PKW(P0,8), pw1[1]=PKW(P0,10), pw1); \
    VRD(5); SBAR(); GAPA(C1=__builtin_amdgcn_mfma_f32_32x32x16_bf16(kf[3],qr[1],C1,0,0,0),   P0[14],P0[15],P1[0],P1[1],   pw1[2]=PKW(P0,12),pw1[3]=PKW(P0,14), pw1); \
    VRD(2); SBAR(); GAPA(C0=__builtin_amdgcn_mfma_f32_32x32x16_bf16(kf[4],qr[2],C0,0,0,0),   P1[2],P1[3],P1[4],P1[5],     pw2[0]=PKW(P1,0), pw2[1]=PKW(P1,2), pw2); \
    VRD(6); SBAR(); GAPA(C1=__builtin_amdgcn_mfma_f32_32x32x16_bf16(kf[5],qr[2],C1,0,0,0),   P1[6],P1[7],P1[8],P1[9],     pw2[2]=PKW(P1,4), pw2[3]=PKW(P1,6), pw2); \
    VRD(3); SBAR(); GAPA(C0=__builtin_amdgcn_mfma_f32_32x32x16_bf16(kf[6],qr[3],C0,0,0,0),   P1[10],P1[11],P1[12],P1[13], pw3[0]=PKW(P1,8), pw3[1]=PKW(P1,10), pw3); \
    VRD(7); SBAR(); GAPA(C1=__builtin_amdgcn_mfma_f32_32x32x16_bf16(kf[7],qr[3],C1,0,0,0),   P1[14],P1[15],0.f,0.f,       pw3[2]=PKW(P1,12),pw3[3]=PKW(P1,14), pw3); \
    l_reg+=sacc; \
    if(GK){DMA_K((t)+3,sl_cur);} if(GV){DMA_V((t)+1,sl_next);} \
    CMASK(C0,C1,t); \
    { float a=MX3(C0[0],C0[1],C1[0]),b=MX3(C0[2],C0[3],C1[1]); a=MX3(a,C1[2],C1[3]); \
      _Pragma("unroll") for(int r=4;r<16;r+=4){a=MX3(a,C0[r],C0[r+1]);b=MX3(b,C0[r+2],C0[r+3]);a=MX3(a,C1[r],C1[r+1]);b=MX3(b,C1[r+2],C1[r+3]);} \
      float rm=__builtin_fmaxf(a,b); { auto rr=__builtin_amdgcn_permlane32_swap(__float_as_uint(rm),__float_as_uint(rm),false,false); rm=__builtin_fmaxf(__uint_as_float(rr[0]),__uint_as_float(rr[1])); } \
      resc=false; \
      if(__builtin_expect(__any(rm>(float)THRL),0)){ const float dl=__builtin_fmaxf(rm,0.f); mhat+=dl; \
        _Pragma("unroll") for(int r=0;r<16;++r){C0[r]-=dl;C1[r]-=dl;} \
        _Pragma("unroll") for(int r=0;r<16;++r)negm[r]=-mhat; asm volatile("":"+v"(negm)); \
        const float f=__builtin_amdgcn_exp2f(-dl); l_reg*=f; if(hi==0)wsf[r32]=f; resc=true; } } \
    SBAR(); \
    GAPB(o[0]=__builtin_amdgcn_mfma_f32_32x32x16_bf16(PAF(0),VFR(0),o[0],0,0,0), C0,0); \
    GAPB(o[1]=__builtin_amdgcn_mfma_f32_32x32x16_bf16(PAF(0),VFR(4),o[1],0,0,0), C0,4); \
    KRD(GL,0); GAPB(o[0]=__builtin_amdgcn_mfma_f32_32x32x16_bf16(PAF(1),VFR(1),o[0],0,0,0), C0,8); \
    KRD(GL,1); GAPB(o[1]=__builtin_amdgcn_mfma_f32_32x32x16_bf16(PAF(1),VFR(5),o[1],0,0,0), C0,12); \
    KRD(GL,2); GAPB(o[0]=__builtin_amdgcn_mfma_f32_32x32x16_bf16(PAF(2),VFR(2),o[0],0,0,0), C1,0); \
    KRD(GL,3); GAPB(o[1]=__builtin_amdgcn_mfma_f32_32x32x16_bf16(PAF(2),VFR(6),o[1],0,0,0), C1,4); \
    GAPB(o[0]=__builtin_amdgcn_mfma_f32_32x32x16_bf16(PAF(3),VFR(3),o[0],0,0,0), C1,8); \
    GAPB(o[1]=__builtin_amdgcn_mfma_f32_32x32x16_bf16(PAF(3),VFR(7),o[1],0,0,0), C1,12); \
    }while(0)
  int t=1;
  #undef CMASK
  #define CMASK(P0,P1,t) do{}while(0)
  for(;t+5<NT;t+=2){
    STEP(pB0,pB1,pA0,pA1,t,true,true,true);     WAIT_BAR(2); RESC(); ROT();
    STEP(pA0,pA1,pB0,pB1,t+1,true,true,true);   WAIT_BAR(2); RESC(); ROT();
  }
  #undef CMASK
  #define CMASK(P0,P1,t) do{}while(0)
  #define ENDW(tt) do{ if((tt)+3<NT){WAIT_BAR(2);} else if((tt)+2<NT){WAIT_BAR(1);} else {WAIT_BAR(0);} }while(0)
  for(;t+1<NT;t+=2){
    STEP(pB0,pB1,pA0,pA1,t,(t+3<NT),(t+1<NT),(t+1<NT));       ENDW(t);   RESC(); ROT();
    STEP(pA0,pA1,pB0,pB1,t+1,(t+4<NT),(t+2<NT),(t+2<NT));     ENDW(t+1); RESC(); ROT();
  }
  STEP(pB0,pB1,pA0,pA1,NT-1,false,false,false); RESC();
  { float sacc=pB0[0]+pB0[1]; _Pragma("unroll") for(int r=2;r<16;++r)sacc+=pB0[r]; _Pragma("unroll") for(int r=0;r<16;++r)sacc+=pB1[r]; l_reg+=sacc;
    pw0=(u32x4){PKW(pB0,0),PKW(pB0,2),PKW(pB0,4),PKW(pB0,6)};pw1=(u32x4){PKW(pB0,8),PKW(pB0,10),PKW(pB0,12),PKW(pB0,14)};pw2=(u32x4){PKW(pB1,0),PKW(pB1,2),PKW(pB1,4),PKW(pB1,6)};pw3=(u32x4){PKW(pB1,8),PKW(pB1,10),PKW(pB1,12),PKW(pB1,14)};
    SBAR(); pv(o,vb0+sl_cur,PAF(0),PAF(1),PAF(2),PAF(3)); }
  #undef PKW
  #undef PAF
  #undef VFR
  #undef PIN
  #undef MX3
  #undef GAPA
  #undef GAPB
  #undef EX
  #undef VRD
  #undef KRD
  #undef STEP
  #undef ENDW
  {auto rr=__builtin_amdgcn_permlane32_swap(__float_as_uint(l_reg),__float_as_uint(l_reg),false,false);l_reg=__uint_as_float(rr[0])+__uint_as_float(rr[1]);}
  if(hi==0)wsf[32+r32]=l_reg;asm volatile("s_waitcnt lgkmcnt(0)":::"memory");
  float rli[16];
  #pragma unroll
  for(int r=0;r<16;++r)rli[r]=__builtin_amdgcn_rcpf(wsf[32+crow(r,hi)]);
  bf16*Ow=Oblk+(long)(wid*QBLK)*PO;
  { bf16*stg=(bf16*)(shm+LDS_OST)+wid*2048;
    #pragma unroll
    for(int r=0;r<16;++r){const int orow=crow(r,hi);
      #pragma unroll
      for(int d0=0;d0<2;++d0)stg[orow*64+d0*32+r32]=__float2bfloat16(o[d0][r]*rli[r]);}
    asm volatile("s_waitcnt lgkmcnt(0)":::"memory");
    #pragma unroll
    for(int i=0;i<4;++i){const int row=i*8+(lane>>3),ch=lane&7; const u32x4 v=*(const u32x4*)(stg+row*64+ch*8); ATTN_STORE16(Ow+(long)row*PO+ch*8,v);} }
  asm volatile("s_waitcnt lgkmcnt(0)\n\ts_barrier":::"memory");
  #undef DMA_K
  #undef DMA_V
  #undef CMASK
  #undef START
  #undef RESC
  #undef ROT
}
#undef SBAR
#undef WAIT_BAR
}

typedef unsigned short bf16_t;
typedef float f32x4 __attribute__((ext_vector_type(4)));
typedef short bf16x8 __attribute__((ext_vector_type(8)));
typedef unsigned u32x4 __attribute__((ext_vector_type(4)));
#define LASP __attribute__((address_space(3)))

constexpr int D = 1024, NB = 4, SEQ = 8192, CTX = 256, TB = SEQ + CTX, M = NB * TB;
constexpr int INW = 6432, NMIX = 3360, PMW = 3584, NGATE = 3072, YW = 1536, FH = 2816, F2 = 5632;
constexpr int C_U = 0, C_V = 512, C_Q = 1024, C_K = 1536, C_VV = 1664, C_GQ = 1792, C_GK = 2048, C_GV = 2304, C_AF = 2816, C_AB = 2832, C_GR = 2848;
constexpr float EPS = 1e-6f;
constexpr int NTHR = 512, NWV = 8;
constexpr int LDS_BYTES = 147456, LDS_SLOT = 147392;
constexpr size_t MiB = 1u << 20;
constexpr size_t WS_CTL = 0, WS_MOD = 65536;
constexpr size_t W_MIX = 1 * MiB, W_GATE = W_MIX + (size_t)PMW * D * 2, W_BR = W_GATE + (size_t)NGATE * D * 2, W_OUT = W_BR + (size_t)3 * D * 512 * 2,
                 W_UP = W_OUT + (size_t)D * D * 2, W_DOWN = W_UP + (size_t)F2 * D * 2, W_END = W_DOWN + (size_t)D * FH * 2;
static_assert(W_END <= 36 * MiB, "weights");
constexpr int GLA_NSC = 17, GLA_UNITS_A = NB * 4 * 2 * GLA_NSC;
constexpr size_t WS_GU = 36 * MiB, WS_GD = 53 * MiB, WS_XC = 54 * MiB, WS_HB = 58 * MiB, WS_R = 124 * MiB;
constexpr size_t WS_PM = WS_R, WS_Y = WS_R + 231 * MiB, WS_G = WS_R, WS_A = WS_R, WS_HALO = 488 * MiB, WS_END = 512 * MiB;
static_assert((size_t)GLA_UNITS_A * 32768 <= 17 * MiB && (size_t)M * PMW * 2 == 231 * MiB && (size_t)M * F2 * 2 <= 364 * MiB && WS_HALO + (size_t)(M / 32) * F2 * 2 <= WS_END, "ws map");

struct KArgs { const float* in[26]; float* out; unsigned char* ws; };
__device__ __forceinline__ unsigned long long sgpr64(unsigned long long p) { unsigned lo = (unsigned)p, hi = (unsigned)(p >> 32); asm volatile("" : "+v"(lo), "+v"(hi)); lo = __builtin_amdgcn_readfirstlane(lo); hi = __builtin_amdgcn_readfirstlane(hi); return ((unsigned long long)hi << 32) | lo; }
__device__ __forceinline__ unsigned long long araw(const KArgs& a, int k) { asm volatile("" : "+s"(k)); return ((const unsigned long long*)&a)[k]; }
#define GASP __attribute__((address_space(1)))
__device__ __forceinline__ unsigned char* wsp(const KArgs& a) { return (unsigned char*)(GASP unsigned char*)araw(a, 27); }
__device__ __forceinline__ float* outp(const KArgs& a) { return (float*)(GASP float*)araw(a, 26); }
__device__ __forceinline__ const float* ain(const KArgs& a, int k) { asm volatile("" : "+s"(k)); return (const float*)(GASP const float*)(unsigned long long)a.in[k]; }

__device__ __forceinline__ int opaque(int x) { asm volatile("" : "+v"(x)); return x; }
typedef float f32x2_t_ __attribute__((ext_vector_type(2))); typedef __bf16 bf16x2_t_ __attribute__((ext_vector_type(2)));
__device__ __forceinline__ unsigned pk2(float lo, float hi) { f32x2_t_ v = {lo, hi}; bf16x2_t_ b = __builtin_convertvector(v, bf16x2_t_); return __builtin_bit_cast(unsigned, b); }
__device__ __forceinline__ unsigned f2bf(float f) { return pk2(f, 0.f) & 0xffffu; }
__device__ __forceinline__ float bf2f(unsigned b) { return __uint_as_float(b << 16); }
__device__ __forceinline__ float bflo(unsigned w) { return __uint_as_float(w << 16); }
__device__ __forceinline__ float bfhi(unsigned w) { return __uint_as_float(w & 0xffff0000u); }
__device__ __forceinline__ float wave_sum(float v) {
#pragma unroll
    for (int o = 1; o < 64; o <<= 1) v += __shfl_xor(v, o);
    return v;
}
__device__ __forceinline__ float fexp(float x) { return __builtin_amdgcn_exp2f(x * 1.4426950408889634f); }
__device__ __forceinline__ float flog(float x) { return __builtin_amdgcn_logf(x) * 0.6931471805599453f; }
__device__ __forceinline__ float sigmoidf_(float x) { return __builtin_amdgcn_rcpf(1.0f + fexp(-x)); }
__device__ __forceinline__ float siluf_(float x) { return x * __builtin_amdgcn_rcpf(1.0f + fexp(-x)); }
__device__ __forceinline__ float gelu_tanh(float x) { const float y = 0.7978845608028654f * (x + 0.044715f * x * x * x); const float t = 1.0f - 2.0f * __builtin_amdgcn_rcpf(1.0f + fexp(2.0f * y)); return 0.5f * x * (1.0f + t); }

struct XPtrs { const float* in_lat; const float* in_ctx; float* out_lat; float* out_ctx; };
__device__ __forceinline__ XPtrs xptrs(const KArgs& a, int l) {
    XPtrs x; float* xc = (float*)(wsp(a) + WS_XC);
    x.in_lat = l == 0 ? ain(a, 0) : outp(a); x.in_ctx = l == 0 ? ain(a, 2) : xc; x.out_lat = outp(a); x.out_ctx = xc; return x;
}

namespace pg8 {
template <int ACT, bool HALO> struct EpiStore {
    static constexpr bool PERM = true, AFTER_DRAIN = false;
    bf16_t* O; int ldc; bf16_t* halo;
    __device__ __forceinline__ void operator()(const f32x4 (&acc)[2][2][4][2], const Unit& u, int wr, int wc, int fr, int fq) const {
        const int row0 = u.pm * BM + wr * 64 + fr, col0 = u.pn * BM + wc * 32 + 8 * fq;
#pragma unroll
        for (int ai = 0; ai < 2; ++ai)
#pragma unroll
            for (int m = 0; m < 4; ++m) {
                const int r = row0 + ai * HALF + m * 16; bf16_t* rowp = O + (size_t)r * ldc + col0;
                const bool hz = HALO && (((m & 1) == 0 && fr == 0) || ((m & 1) == 1 && fr == 15));
#pragma unroll
                for (int bj = 0; bj < 2; ++bj) {
                    f32x4 v0 = acc[ai][bj][m][0], v1 = acc[ai][bj][m][1];
                    if (ACT == 2) {
#pragma unroll
                        for (int e = 0; e < 4; ++e) { v0[e] = sigmoidf_(v0[e]); v1[e] = sigmoidf_(v1[e]); }
                    }
                    u32x4 w; w.x = pk2(v0[0], v0[1]); w.y = pk2(v0[2], v0[3]); w.z = pk2(v1[0], v1[1]); w.w = pk2(v1[2], v1[3]);
                    *(u32x4*)(rowp + bj * HALF) = w;
                    if (hz) *(u32x4*)(halo + (size_t)((r >> 5) * 2 + (m & 1)) * ldc + col0 + bj * HALF) = w;
                }
            }
    }
};
struct EpiBranch {
    static constexpr bool PERM = true, AFTER_DRAIN = false;
    bf16_t* Mg; const bf16_t* G; int first;
    __device__ __forceinline__ void operator()(const f32x4 (&acc)[2][2][4][2], const Unit& u, int wr, int wc, int fr, int fq) const {
        const int row0 = u.pm * BM + wr * 64 + fr, col0 = u.pn * BM + wc * 32 + 8 * fq;
#pragma unroll
        for (int ai = 0; ai < 2; ++ai)
#pragma unroll
            for (int m = 0; m < 4; ++m) {
                const int r = row0 + ai * HALF + m * 16;
#pragma unroll
                for (int bj = 0; bj < 2; ++bj) {
                    const int c = col0 + bj * HALF;
                    const u32x4 g = *(const u32x4*)(G + (size_t)r * NGATE + c);
                    u32x4 o = (u32x4){0u, 0u, 0u, 0u};
                    if (!first) o = *(const u32x4*)(Mg + (size_t)r * D + c);
                    const f32x4 v0 = acc[ai][bj][m][0], v1 = acc[ai][bj][m][1];
                    u32x4 w;
                    w.x = pk2(bflo(o.x) + bflo(g.x) * v0[0], bfhi(o.x) + bfhi(g.x) * v0[1]);
                    w.y = pk2(bflo(o.y) + bflo(g.y) * v0[2], bfhi(o.y) + bfhi(g.y) * v0[3]);
                    w.z = pk2(bflo(o.z) + bflo(g.z) * v1[0], bfhi(o.z) + bfhi(g.z) * v1[1]);
                    w.w = pk2(bflo(o.w) + bflo(g.w) * v1[2], bfhi(o.w) + bfhi(g.w) * v1[3]);
                    *(u32x4*)(Mg + (size_t)r * D + c) = w;
                }
            }
    }
};
struct EpiResid {
    static constexpr bool PERM = false, AFTER_DRAIN = false;
    XPtrs X; const float* modl; int gidx; const float* zeros;
    __device__ __forceinline__ void operator()(const f32x4 (&acc)[2][2][4][2], const Unit& u, int wr, int wc, int fr, int fq) const {
        const int b = u.pm / 33, tp = u.pm % 33;
        const float* xin; float* xout; int mr;
        if (tp == 0) { xin = X.in_ctx + (size_t)b * CTX * D; xout = X.out_ctx + (size_t)b * CTX * D; mr = 4; }
        else { const size_t o = ((size_t)b * SEQ + (size_t)(tp - 1) * 256) * D; xin = X.in_lat + o; xout = X.out_lat + o; mr = b; }
        const float* gate = zeros ? zeros : modl + (size_t)mr * 6 * D + (size_t)gidx * D;
        const int col0 = u.pn * BM + wc * 32 + 4 * fq;
#pragma unroll
        for (int bj = 0; bj < 2; ++bj)
#pragma unroll
            for (int n = 0; n < 2; ++n) {
                const int c = col0 + bj * HALF + 16 * n;
                const f32x4 gv = *(const f32x4*)(gate + c);
#pragma unroll
                for (int ai = 0; ai < 2; ++ai)
#pragma unroll
                    for (int m = 0; m < 4; ++m) {
                        const int rr = ai * HALF + wr * 64 + m * 16 + fr;
                        const f32x4 xv = *(const f32x4*)(xin + (size_t)rr * D + c);
                        *(f32x4*)(xout + (size_t)rr * D + c) = xv + gv * acc[ai][bj][m][n];
                        if (m == 3) __builtin_amdgcn_sched_barrier(0);
                    }
            }
    }
};
struct RowOrder {
    StaticOrder s; int lat;
    __device__ void init(int N, int G_, int c_, int lat_) { lat = lat_; s.init(lat_ ? 128 * BM : M, N, G_, c_); }
    __device__ bool next(int i, Unit& u) const { if (!s.next(i, u)) return false; if (lat) u.pm = (u.pm >> 5) * 33 + 1 + (u.pm & 31); return true; }
    __device__ __forceinline__ void a_ready(const Unit&) const {}
    __device__ __forceinline__ void done(const Unit&) const {}
};
}

__device__ __forceinline__ void transpose_item(const float* W, int ldw, int c0, int nvalid, int K, bf16_t* WT, float* scr, int kb, int nb, int lane) {
    const int k0 = 64 * kb, n0 = 32 * nb;
#pragma unroll 8
    for (int i = 0; i < 32; ++i) { const int kk = 2 * i + (lane >> 5), n = n0 + (lane & 31); scr[kk * 33 + (lane & 31)] = (n < nvalid) ? W[(size_t)(k0 + kk) * ldw + c0 + n] : 0.f; }
    asm volatile("s_waitcnt lgkmcnt(0)" ::: "memory");
    const int c = lane & 7;
#pragma unroll
    for (int j = 0; j < 4; ++j) { const int n = (lane >> 3) + 8 * j; const float* s = scr + (8 * c) * 33 + n;
        u32x4 o; o.x = pk2(s[0 * 33], s[1 * 33]); o.y = pk2(s[2 * 33], s[3 * 33]); o.z = pk2(s[4 * 33], s[5 * 33]); o.w = pk2(s[6 * 33], s[7 * 33]);
        *(u32x4*)(WT + (size_t)(n0 + n) * K + k0 + 8 * c) = o; }
    asm volatile("s_waitcnt lgkmcnt(0)" ::: "memory");
}
__device__ __forceinline__ void convert_weights(const KArgs& a, int l, char* lds, int gw, int ngw, int wave, int lane) {
    float* scr = (float*)(lds + wave * 8704);
    unsigned char* ws = a.ws;
    constexpr int I0 = 16 * 112, I1 = 16 * 96, I2 = 8 * 32, I5 = 16 * 32, I6 = 16 * 176, I7 = 44 * 32;
    constexpr int TOT = I0 + I1 + 3 * I2 + I5 + I6 + I7;
    for (int it = gw; it < TOT; it += ngw) {
        int r = it;
        if (r < I0) { transpose_item(ain(a, 8) + (size_t)l * D * INW, INW, 0, NMIX, D, (bf16_t*)(wsp(a) + W_MIX), scr, r / 112, r % 112, lane); continue; } r -= I0;
        if (r < I1) { transpose_item(ain(a, 8) + (size_t)l * D * INW, INW, NMIX, NGATE, D, (bf16_t*)(wsp(a) + W_GATE), scr, r / 96, r % 96, lane); continue; } r -= I1;
        if (r < 3 * I2) { const int bi = r / I2, rr = r % I2; transpose_item(ain(a, 17 + bi) + (size_t)l * 512 * D, D, 0, D, 512, (bf16_t*)(wsp(a) + W_BR) + (size_t)bi * D * 512, scr, rr / 32, rr % 32, lane); continue; } r -= 3 * I2;
        if (r < I5) { transpose_item(ain(a, 20) + (size_t)l * D * D, D, 0, D, D, (bf16_t*)(wsp(a) + W_OUT), scr, r / 32, r % 32, lane); continue; } r -= I5;
        if (r < I6) { transpose_item(ain(a, 21) + (size_t)l * D * F2, F2, 0, F2, D, (bf16_t*)(wsp(a) + W_UP), scr, r / 176, r % 176, lane); continue; } r -= I6;
        transpose_item(ain(a, 24) + (size_t)l * FH * D, D, 0, D, FH, (bf16_t*)(wsp(a) + W_DOWN), scr, r / 32, r % 32, lane);
    }
}

__device__ __forceinline__ void mods_phase(const KArgs& a, char* lds, int tid) {
    float* sc = (float*)lds;
    float* red = (float*)(lds + 20480);
    { const float* cin = ain(a, 1); const float* cctx = ain(a, 3);
    for (int e = tid; e < 5 * D; e += NTHR) { const int r = e >> 10, k = e & 1023; const float v = r < 4 ? cin[r * D + k] : cctx[k]; sc[e] = siluf_(v); } }
    __syncthreads();
    float* MOD = (float*)(wsp(a) + WS_MOD);
    const float* bada = ain(a, 5);
    const int col = tid & 63, kg = tid >> 6;
    for (int strip = blockIdx.x; strip < 192; strip += gridDim.x) {
        const int l = strip / 96, n = (strip % 96) * 64 + col;
        const float* w = ain(a, 4) + (size_t)l * D * 6144 + n;
        float acc[5] = {0.f, 0.f, 0.f, 0.f, 0.f};
#pragma unroll 8
        for (int k = kg * 128; k < kg * 128 + 128; ++k) { const float wv = w[(size_t)k * 6144];
#pragma unroll
            for (int r = 0; r < 5; ++r) acc[r] += sc[r * D + k] * wv; }
#pragma unroll
        for (int r = 0; r < 5; ++r) red[(kg * 5 + r) * 64 + col] = acc[r];
        __syncthreads();
        if (tid < 320) { const int r = tid >> 6, c = tid & 63; float s = 0.f;
#pragma unroll
            for (int g = 0; g < 8; ++g) s += red[(g * 5 + r) * 64 + c];
            const int nn = (strip % 96) * 64 + c; MOD[((size_t)l * 5 + r) * 6144 + nn] = s + bada[(size_t)l * 6144 + nn]; }
        __syncthreads();
    }
}

__device__ __forceinline__ void norm_phase(const KArgs& a, int l, int which, const float* in_lat, const float* in_ctx, int gw, int ngw, int lane) {
    const float* g = ain(a, which == 1 ? 6 : 7) + (size_t)l * D;
    const float* MODl = (const float*)(wsp(a) + WS_MOD) + (size_t)l * 5 * 6144;
    bf16_t* HB = (bf16_t*)(wsp(a) + WS_HB);
    const int si = which == 1 ? 0 : 3;
    for (int r = gw; r < M; r += ngw) {
        const int b = r / TB, p = r % TB;
        const float* src = p < CTX ? in_ctx + ((size_t)b * CTX + p) * D : in_lat + ((size_t)b * SEQ + (p - CTX)) * D;
        const float* md = MODl + (size_t)(p < CTX ? 4 : b) * 6144;
        f32x4 v[4]; float ss = 0.f;
#pragma unroll
        for (int j = 0; j < 4; ++j) { v[j] = *(const f32x4*)(src + (lane + 64 * j) * 4); ss += (v[j][0] * v[j][0] + v[j][1] * v[j][1]) + (v[j][2] * v[j][2] + v[j][3] * v[j][3]); }
        const float rstd = __builtin_amdgcn_rsqf(wave_sum(ss) * (1.0f / D) + EPS);
#pragma unroll
        for (int j = 0; j < 4; ++j) {
            const int k = (lane + 64 * j) * 4;
            const f32x4 gv = *(const f32x4*)(g + k), sh = *(const f32x4*)(md + si * D + k), scl = *(const f32x4*)(md + (si + 1) * D + k);
            f32x4 h;
#pragma unroll
            for (int e = 0; e < 4; ++e) h[e] = (v[j][e] * rstd * gv[e]) * (1.0f + scl[e]) + sh[e];
            uint2 o; o.x = pk2(h[0], h[1]); o.y = pk2(h[2], h[3]);
            *(uint2*)(HB + (size_t)r * D + k) = o;
        }
    }
}

template <bool ISQ>
__device__ __forceinline__ void qk_item(bf16_t* PM, bf16_t* DUM, bool dry, int row, int head, int j, const float (&g)[8], const float (&invf)[2], const unsigned (&wv)[4]) {
    const int p = row % TB;
    bf16_t* base = PM + (size_t)row * PMW + C_Q + head * 64 + 2 * j;
    float x[8]; float ss = 0.f;
#pragma unroll
    for (int q = 0; q < 4; ++q) { x[2 * q] = bflo(wv[q]); x[2 * q + 1] = bfhi(wv[q]); ss += x[2 * q] * x[2 * q] + x[2 * q + 1] * x[2 * q + 1]; }
    ss += __shfl_xor(ss, 1); ss += __shfl_xor(ss, 2); ss += __shfl_xor(ss, 4);
    const float rstd = __builtin_amdgcn_rsqf(ss * (1.0f / 64.0f) + EPS);
    float y[8];
#pragma unroll
    for (int i = 0; i < 8; ++i) y[i] = x[i] * rstd * g[i];
    if (p >= CTX) {
        const int t = p - CTX;
#pragma unroll
        for (int ax = 0; ax < 2; ++ax) { const float pos = (float)(ax ? (t & 63) : (t >> 6));
#pragma unroll
            for (int e = 0; e < 2; ++e) { float rev = pos * invf[e] * 0.15915494309189535f; rev -= floorf(rev);
                const float sn = __builtin_amdgcn_sinf(rev), cs = __builtin_amdgcn_cosf(rev);
                const float x1 = y[4 * ax + e], x2 = y[4 * ax + 2 + e];
                y[4 * ax + e] = x1 * cs - x2 * sn; y[4 * ax + 2 + e] = x1 * sn + x2 * cs; } }
    }
    if (dry) base = DUM + (size_t)row * 640 + head * 64 + 2 * j;
#pragma unroll
    for (int q = 0; q < 4; ++q) *(unsigned*)(base + 16 * q) = pk2(y[2 * q], y[2 * q + 1]);
}
__device__ __forceinline__ void qk_phase(const KArgs& a, int l, int gw, int ngw, int lane, bool dry) {
    bf16_t* PM = (bf16_t*)(wsp(a) + WS_PM); bf16_t* DUM = (bf16_t*)(wsp(a) + WS_Y);
    const int j = lane & 7, item = lane >> 3;
    constexpr float C2 = 0.125f * 1.4426950408889634f;
    float gq[8], gk[8], invf[2];
    { const float* qg = ain(a, 9) + l * 64; const float* kg = ain(a, 10) + l * 64;
#pragma unroll
      for (int q = 0; q < 4; ++q)
#pragma unroll
          for (int e = 0; e < 2; ++e) { gq[2 * q + e] = qg[16 * q + 2 * j + e] * C2; gk[2 * q + e] = kg[16 * q + 2 * j + e]; } }
#pragma unroll
    for (int e = 0; e < 2; ++e) invf[e] = exp2f(-(float)(2 * j + e) * (13.287712379549449f / 16.0f));
    for (int r4 = gw * 4; r4 < M; r4 += ngw * 4) {
        unsigned wq[4][4], wk[4];
#pragma unroll
        for (int p = 0; p < 4; ++p)
#pragma unroll
            for (int q = 0; q < 4; ++q) wq[p][q] = *(const unsigned*)(PM + (size_t)(r4 + p) * PMW + C_Q + item * 64 + 2 * j + 16 * q);
#pragma unroll
        for (int q = 0; q < 4; ++q) wk[q] = *(const unsigned*)(PM + (size_t)(r4 + (item >> 1)) * PMW + C_Q + (8 + (item & 1)) * 64 + 2 * j + 16 * q);
#pragma unroll
        for (int p = 0; p < 4; ++p) qk_item<true>(PM, DUM, dry, r4 + p, item, j, gq, invf, wq[p]);
        qk_item<false>(PM, DUM, dry, r4 + (item >> 1), 8 + (item & 1), j, gk, invf, wk);
    }
}

__device__ __forceinline__ bf16x8 ldfrag(const bf16_t* base, int pitch, int row0, int k0, int lane) {
    return *(const bf16x8*)(base + (size_t)(row0 + (lane & 15)) * pitch + k0 + (lane >> 4) * 8);
}
__device__ __forceinline__ int swz(int row, int col) { return row * 72 + ((((col >> 3) ^ (row >> 3)) & 7) << 3) + (col & 7); }
__device__ __forceinline__ bf16x8 ldfrag_sw(const bf16_t* base, int row0, int k0, int lane) {
    const int row = row0 + (lane & 15), ch = (k0 >> 3) + (lane >> 4);
    return *(const bf16x8*)(base + row * 72 + (((ch ^ (row >> 3)) & 7) << 3));
}
#define MFMA16(a, b, c) __builtin_amdgcn_mfma_f32_16x16x32_bf16((a), (b), (c), 0, 0, 0)

constexpr int GL_W2 = 0, GL_LA = 4608, GL_QIN = 21248, GL_KIN = 30464, GL_KST = 39680, GL_ATT = 48896, GL_VT = 58112, GL_ST = 76544, GL_DEC = 94976, GL_OT = 95232, GL_END = 129024;
constexpr int GP = 72;

__device__ __forceinline__ void gla_load_w2(const KArgs& a, int l, int h, int dir, char* lds, int tid) {
    bf16_t* W2T = (bf16_t*)(lds + GL_W2); float* B2 = (float*)(lds + GL_W2 + 4096);
    const float* w = ain(a, 14) + ((size_t)(l * 2 + dir) * 16) * 256 + h * 64;
    const float* bal = ain(a, 15);
    for (int e = tid; e < 64 * 32; e += NTHR) { const int d = e >> 5, k = e & 31; const int kk = k - 16 * dir;
        W2T[e] = (kk >= 0 && kk < 16) ? (bf16_t)f2bf(w[(size_t)kk * 256 + d]) : (bf16_t)0; }
    if (tid < 64) B2[tid] = bal[(size_t)(l * 2 + dir) * 256 + h * 64 + tid];
    __syncthreads();
}

struct GlaRegs { u32x4 a0, qv, kv, v0, v1, r0v, r1v; };
template <bool PC>
__device__ __forceinline__ void gla_fetch(GlaRegs& R, const bf16_t* PM, int r0, int h, int dir, int tid) {
    const int i = tid >> 3, sub = tid & 7;
    const bf16_t* rowp = PM + (size_t)(r0 + i) * PMW;
    R.a0 = *(const u32x4*)(PM + (size_t)(r0 + (tid >> 7) * 16 + (tid & 15)) * PMW + C_AF + ((tid >> 4) & 3) * 8);
    if (PC) R.qv = *(const u32x4*)(rowp + C_GQ + h * 64 + sub * 8);
    R.kv = *(const u32x4*)(rowp + C_GK + h * 64 + sub * 8);
    R.v0 = *(const u32x4*)(rowp + C_GV + h * 128 + sub * 16); R.v1 = *(const u32x4*)(rowp + C_GV + h * 128 + sub * 16 + 8);
    if (PC && dir) { R.r0v = *(const u32x4*)(rowp + C_GR + h * 128 + sub * 16); R.r1v = *(const u32x4*)(rowp + C_GR + h * 128 + sub * 16 + 8); }
}
template <bool PC>
__device__ __forceinline__ void gla_step(char* lds, const bf16_t* PM, bf16_t* Y, const float* gng, int r0, int r0n, GlaRegs& R, int h, int dir, f32x4 (&s)[4], float (&dprod)[4], int tid, int lane, int w) {
    float* LA = (float*)(lds + GL_LA); float* DEC = (float*)(lds + GL_DEC); float* OT = (float*)(lds + GL_OT);
    bf16_t* QIN = (bf16_t*)(lds + GL_QIN); bf16_t* KIN = (bf16_t*)(lds + GL_KIN); bf16_t* KST = (bf16_t*)(lds + GL_KST);
    bf16_t* ATT = (bf16_t*)(lds + GL_ATT); bf16_t* VT = (bf16_t*)(lds + GL_VT); bf16_t* ST = (bf16_t*)(lds + GL_ST);
    const int i = tid >> 3, sub = tid & 7, l15 = lane & 15, q4 = lane >> 4;
    const bf16_t* rowp = PM + (size_t)(r0 + i) * PMW;
    const u32x4 a0 = R.a0, qv = R.qv, kv = R.kv, v0 = R.v0, v1 = R.v1, r0v = R.r0v, r1v = R.r1v;
    if (r0n >= 0) gla_fetch<PC>(R, PM, r0n, h, dir, tid);
    {
        const bf16_t* W2T = (const bf16_t*)(lds + GL_W2); const float* B2 = (const float*)(lds + GL_W2 + 4096);
        const bf16x8 af = __builtin_bit_cast(bf16x8, a0);
#pragma unroll
        for (int t2 = 0; t2 < 2; ++t2) { const int nj = 2 * (w & 1) + t2;
            const bf16x8 bfr = *(const bf16x8*)(W2T + (size_t)(nj * 16 + l15) * 32 + q4 * 8);
            const f32x4 z4 = MFMA16(af, bfr, ((f32x4){0.f, 0.f, 0.f, 0.f}));
            const float b2 = B2[nj * 16 + l15];
#pragma unroll
            for (int j = 0; j < 4; ++j) { const float z = z4[j] + b2; const float ls = fminf(z, 0.f) - flog(1.0f + fexp(-fabsf(z)));
                LA[((w >> 1) * 16 + q4 * 4 + j) * 65 + nj * 16 + l15] = ls * (1.0f / 16.0f); } }
    }
    __syncthreads();
    {
        float* SEG = OT;
        float p[8];
#pragma unroll
        for (int r = 0; r < 8; ++r) p[r] = LA[(w * 8 + r) * 65 + lane];
        if (!dir) {
#pragma unroll
            for (int r = 1; r < 8; ++r) p[r] += p[r - 1];
            SEG[w * 64 + lane] = p[7];
        } else {
#pragma unroll
            for (int r = 6; r >= 0; --r) p[r] += p[r + 1];
            SEG[w * 64 + lane] = p[0];
        }
        __syncthreads();
        float off = 0.f;
#pragma unroll
        for (int g = 0; g < 8; ++g) { const float sv = SEG[g * 64 + lane]; off += (dir ? (g > w) : (g < w)) ? sv : 0.f; }
#pragma unroll
        for (int r = 0; r < 8; ++r) LA[(w * 8 + r) * 65 + lane] = p[r] + off;
    }
    __syncthreads();
    {
        const int lastrow = dir ? 0 : 63;
        float qf[8], kf[8];
        qf[0] = bflo(qv.x); qf[1] = bfhi(qv.x); qf[2] = bflo(qv.y); qf[3] = bfhi(qv.y); qf[4] = bflo(qv.z); qf[5] = bfhi(qv.z); qf[6] = bflo(qv.w); qf[7] = bfhi(qv.w);
        kf[0] = bflo(kv.x); kf[1] = bfhi(kv.x); kf[2] = bflo(kv.y); kf[3] = bfhi(kv.y); kf[4] = bflo(kv.z); kf[5] = bfhi(kv.z); kf[6] = bflo(kv.w); kf[7] = bfhi(kv.w);
#pragma unroll
        for (int dd = 0; dd < 8; ++dd) { const int d = sub * 8 + dd; const float cum = LA[i * 65 + d], tot = LA[lastrow * 65 + d];
            if (PC) { QIN[i * GP + d] = (bf16_t)f2bf(qf[dd] * 0.125f * fexp(cum)); KIN[i * GP + d] = (bf16_t)f2bf(kf[dd] * fexp(-cum)); }
            KST[swz(d, i)] = (bf16_t)f2bf(kf[dd] * fexp(tot - cum));
            if (i == 0) DEC[d] = fexp(tot); }
        const unsigned vw[8] = {v0.x, v0.y, v0.z, v0.w, v1.x, v1.y, v1.z, v1.w};
#pragma unroll
        for (int e = 0; e < 8; ++e) { VT[swz(sub * 16 + 2 * e, i)] = (bf16_t)(vw[e] & 0xffffu); VT[swz(sub * 16 + 2 * e + 1, i)] = (bf16_t)(vw[e] >> 16); }
    }
    __syncthreads();
    f32x4 o[4];
    if (PC) {
        const int mi = w >> 1;
#pragma unroll
        for (int t2 = 0; t2 < 2; ++t2) { const int nj = 2 * (w & 1) + t2; f32x4 acc = (f32x4){0.f, 0.f, 0.f, 0.f};
#pragma unroll
            for (int k0 = 0; k0 < 64; k0 += 32) acc = MFMA16(ldfrag(QIN, GP, mi * 16, k0, lane), ldfrag(KIN, GP, nj * 16, k0, lane), acc);
#pragma unroll
            for (int j = 0; j < 4; ++j) { const int ii = mi * 16 + q4 * 4 + j, jj = nj * 16 + l15; const bool keep = dir ? (jj >= ii) : (jj <= ii);
                ATT[ii * GP + jj] = (bf16_t)f2bf(keep ? acc[j] : 0.f); } }
#pragma unroll
        for (int n = 0; n < 4; ++n)
#pragma unroll
            for (int j = 0; j < 4; ++j) ST[(16 * w + q4 * 4 + j) * GP + 16 * n + l15] = (bf16_t)f2bf(s[n][j]);
        __syncthreads();
#pragma unroll
        for (int m2 = 0; m2 < 4; ++m2) { f32x4 acc = (f32x4){0.f, 0.f, 0.f, 0.f};
#pragma unroll
            for (int k0 = 0; k0 < 64; k0 += 32) { acc = MFMA16(ldfrag(ATT, GP, m2 * 16, k0, lane), ldfrag_sw(VT, 16 * w, k0, lane), acc);
                acc = MFMA16(ldfrag(QIN, GP, m2 * 16, k0, lane), ldfrag(ST, GP, 16 * w, k0, lane), acc); }
            o[m2] = acc; }
    }
#pragma unroll
    for (int n = 0; n < 4; ++n) { const float dc = DEC[16 * n + l15]; f32x4 acc = s[n] * dc;
#pragma unroll
        for (int k0 = 0; k0 < 64; k0 += 32) acc = MFMA16(ldfrag_sw(VT, 16 * w, k0, lane), ldfrag_sw(KST, 16 * n, k0, lane), acc);
        s[n] = acc; dprod[n] *= dc; }
    if (PC) {
        bf16_t* yb = Y + (size_t)r0 * YW + 1024 + h * 128 + 16 * w + l15;
        if (!dir) {
#pragma unroll
            for (int m2 = 0; m2 < 4; ++m2)
#pragma unroll
                for (int j = 0; j < 4; ++j) yb[(size_t)(m2 * 16 + q4 * 4 + j) * YW] = (bf16_t)f2bf(o[m2][j]);
        } else {
#pragma unroll
            for (int m2 = 0; m2 < 4; ++m2)
#pragma unroll
                for (int j = 0; j < 4; ++j) { const int tok = m2 * 16 + q4 * 4 + j; OT[tok * 132 + 16 * w + l15] = o[m2][j] + bf2f(yb[(size_t)tok * YW]); }
            __syncthreads();
            float vals[16]; float ss = 0.f;
#pragma unroll
            for (int e = 0; e < 16; ++e) { vals[e] = OT[i * 132 + sub * 16 + e]; ss += vals[e] * vals[e]; }
            ss += __shfl_xor(ss, 1); ss += __shfl_xor(ss, 2); ss += __shfl_xor(ss, 4);
            const float rstd = __builtin_amdgcn_rsqf(ss * (1.0f / 128.0f) + EPS);
            const unsigned rw[8] = {r0v.x, r0v.y, r0v.z, r0v.w, r1v.x, r1v.y, r1v.z, r1v.w};
            unsigned ow[8];
#pragma unroll
            for (int e = 0; e < 8; ++e) { const float g0 = gng[h * 128 + sub * 16 + 2 * e], g1 = gng[h * 128 + sub * 16 + 2 * e + 1];
                ow[e] = pk2(vals[2 * e] * rstd * g0 * siluf_(bflo(rw[e])), vals[2 * e + 1] * rstd * g1 * siluf_(bfhi(rw[e]))); }
            bf16_t* yo = Y + (size_t)(r0 + i) * YW + 1024 + h * 128 + sub * 16;
            *(u32x4*)yo = (u32x4){ow[0], ow[1], ow[2], ow[3]}; *(u32x4*)(yo + 8) = (u32x4){ow[4], ow[5], ow[6], ow[7]};
        }
    }
    __syncthreads();
}
__device__ __forceinline__ void gla_sc_range(int sc, int& first, int& cnt) { if (sc == 0) { first = 0; cnt = 4; } else { first = 4 + (sc - 1) * 8; cnt = 8; } }

__device__ __forceinline__ void gla_unit_a(const KArgs& a, int l, int unit, char* lds, int tid, int lane, int w) {
    const int sc = unit % GLA_NSC, dir = (unit / GLA_NSC) & 1, h = (unit / (GLA_NSC * 2)) & 3, b = unit / (GLA_NSC * 8);
    const bf16_t* PM = (const bf16_t*)(wsp(a) + WS_PM);
    gla_load_w2(a, l, h, dir, lds, tid);
    f32x4 s[4]; float dprod[4];
#pragma unroll
    for (int n = 0; n < 4; ++n) { s[n] = (f32x4){0.f, 0.f, 0.f, 0.f}; dprod[n] = 1.f; }
    int first, cnt; gla_sc_range(sc, first, cnt);
    GlaRegs R; R.qv = (u32x4){0u, 0u, 0u, 0u}; R.r0v = R.qv; R.r1v = R.qv;
    gla_fetch<false>(R, PM, b * TB + (dir ? first + cnt - 1 : first) * 64, h, dir, tid);
    for (int q = 0; q < cnt; ++q) { const int c = dir ? first + cnt - 1 - q : first + q; const int cn = dir ? c - 1 : c + 1;
        gla_step<false>(lds, PM, nullptr, nullptr, b * TB + c * 64, q + 1 < cnt ? b * TB + cn * 64 : -1, R, h, dir, s, dprod, tid, lane, w); }
    float* Dg = (float*)(wsp(a) + WS_GD) + (size_t)unit * 64;
    float* U = (float*)(wsp(a) + WS_GU) + ((size_t)unit * 8 + w) * 1024;
#pragma unroll
    for (int n = 0; n < 4; ++n)
#pragma unroll
        for (int j = 0; j < 4; ++j) U[(n * 4 + j) * 64 + lane] = s[n][j];
    if (w == 0 && lane < 16) {
#pragma unroll
        for (int n = 0; n < 4; ++n) Dg[16 * n + lane] = dprod[n]; }
}
__device__ __forceinline__ void gla_unit_c(const KArgs& a, int l, int unit  , char* lds, int tid, int lane, int w) {
    const int sc = unit % GLA_NSC, h = (unit / GLA_NSC) & 3, b = unit / (GLA_NSC * 4);
    const bf16_t* PM = (const bf16_t*)(wsp(a) + WS_PM); bf16_t* Y = (bf16_t*)(wsp(a) + WS_Y);
    const float* gng = ain(a, 16) + (size_t)l * 512;
    int first, cnt; gla_sc_range(sc, first, cnt);
    for (int dir = 0; dir < 2; ++dir) {
        GlaRegs R; R.qv = (u32x4){0u, 0u, 0u, 0u}; R.r0v = R.qv; R.r1v = R.qv;
        gla_fetch<true>(R, PM, b * TB + (dir ? first + cnt - 1 : first) * 64, h, dir, tid);
        gla_load_w2(a, l, h, dir, lds, tid);
        f32x4 s[4]; float dprod[4];
#pragma unroll
        for (int n = 0; n < 4; ++n) { s[n] = (f32x4){0.f, 0.f, 0.f, 0.f}; dprod[n] = 1.f; }
        const int ubase = ((b * 4 + h) * 2 + dir) * GLA_NSC;
        const int nprev = sc == 0 ? 0 : (dir == 0 ? sc : 1 + (GLA_NSC - 1 - sc));
#pragma unroll 4
        for (int q = 0; q < nprev; ++q) {
            const int scp = dir == 0 ? q : (q == 0 ? 0 : GLA_NSC - q);
            const float* U = (const float*)(wsp(a) + WS_GU) + ((size_t)(ubase + scp) * 8 + w) * 1024;
            const float* Dg = (const float*)(wsp(a) + WS_GD) + (size_t)(ubase + scp) * 64;
#pragma unroll
            for (int n = 0; n < 4; ++n) { const float dc = Dg[16 * n + (lane & 15)];
#pragma unroll
                for (int j = 0; j < 4; ++j) s[n][j] = s[n][j] * dc + U[(n * 4 + j) * 64 + lane]; }
        }
        for (int q = 0; q < cnt; ++q) { const int c = dir ? first + cnt - 1 - q : first + q; const int cn = dir ? c - 1 : c + 1;
            gla_step<true>(lds, PM, Y, gng, b * TB + c * 64, q + 1 < cnt ? b * TB + cn * 64 : -1, R, h, dir, s, dprod, tid, lane, w); }
    }
}

constexpr int GM_P = 136;
__device__ __forceinline__ void gmlp_unit(const KArgs& a, int l, int unit, char* lds, int tid, int lane, int w) {
    const int g = unit & 3, n = (unit >> 2) % 66, b = unit / 264;
    const int r0 = b * TB + n * 128;
    const bf16_t* PM = (const bf16_t*)(wsp(a) + WS_PM); bf16_t* Y = (bf16_t*)(wsp(a) + WS_Y);
    bf16_t* VT = (bf16_t*)lds; bf16_t* WSs = (bf16_t*)(lds + 128 * GM_P * 2);
    {
        const int i = tid >> 2, part = tid & 3;
        const bf16_t* vp = PM + (size_t)(r0 + i) * PMW + C_V + g * 128 + part * 32;
        float vals[32]; float ss = 0.f;
#pragma unroll
        for (int q = 0; q < 4; ++q) { const u32x4 t = *(const u32x4*)(vp + q * 8); const unsigned tw[4] = {t.x, t.y, t.z, t.w};
#pragma unroll
            for (int e = 0; e < 4; ++e) { const float x0 = gelu_tanh(bflo(tw[e])), x1 = gelu_tanh(bfhi(tw[e])); vals[q * 8 + 2 * e] = x0; vals[q * 8 + 2 * e + 1] = x1; ss += x0 * x0 + x1 * x1; } }
        ss += __shfl_xor(ss, 1); ss += __shfl_xor(ss, 2);
        const float rstd = __builtin_amdgcn_rsqf(ss * (1.0f / 128.0f) + EPS);
        const float* ng = ain(a, 11) + (size_t)l * 512 + g * 128 + part * 32;
#pragma unroll
        for (int e = 0; e < 32; ++e) VT[(part * 32 + e) * GM_P + i] = (bf16_t)f2bf(vals[e] * rstd * ng[e]);
        const float* wsp = ain(a, 12) + (((size_t)l * 4 + g) * 128 + i) * 128 + part * 32;
#pragma unroll
        for (int q = 0; q < 4; ++q) { const f32x4 x0 = *(const f32x4*)(wsp + q * 8), x1 = *(const f32x4*)(wsp + q * 8 + 4);
            u32x4 o; o.x = pk2(x0[0], x0[1]); o.y = pk2(x0[2], x0[3]); o.z = pk2(x1[0], x1[1]); o.w = pk2(x1[2], x1[3]);
            *(u32x4*)(WSs + (size_t)i * GM_P + part * 32 + q * 8) = o; }
    }
    __syncthreads();
    {
        bf16x8 af[4];
#pragma unroll
        for (int kk = 0; kk < 4; ++kk) af[kk] = ldfrag(WSs, GM_P, 16 * w, kk * 32, lane);
        const int l15 = lane & 15, q4 = lane >> 4;
        const float* bs = ain(a, 13) + ((size_t)l * 4 + g) * 128;
        float* FT = (float*)(lds + 2 * 128 * GM_P * 2);
        float bsv[4];
#pragma unroll
        for (int j = 0; j < 4; ++j) bsv[j] = bs[16 * w + q4 * 4 + j];
#pragma unroll
        for (int nt = 0; nt < 8; ++nt) { f32x4 acc = (f32x4){0.f, 0.f, 0.f, 0.f};
#pragma unroll
            for (int kk = 0; kk < 4; ++kk) acc = MFMA16(af[kk], ldfrag(VT, GM_P, 16 * nt, kk * 32, lane), acc);
#pragma unroll
            for (int j = 0; j < 4; ++j) FT[(16 * w + q4 * 4 + j) * 132 + 16 * nt + l15] = acc[j] + bsv[j]; }
    }
    __syncthreads();
    {
        const int i = tid >> 2, part = tid & 3;
        const bf16_t* up = PM + (size_t)(r0 + i) * PMW + C_U + g * 128 + part * 32;
        bf16_t* yp = Y + (size_t)(r0 + i) * YW + g * 128 + part * 32;
        const float* fp = (const float*)(lds + 2 * 128 * GM_P * 2) + i * 132 + part * 32;
#pragma unroll
        for (int q = 0; q < 4; ++q) { const u32x4 t = *(const u32x4*)(up + q * 8); const unsigned tw[4] = {t.x, t.y, t.z, t.w};
            const f32x4 f0 = *(const f32x4*)(fp + q * 8), f1 = *(const f32x4*)(fp + q * 8 + 4);
            u32x4 o;
            o.x = pk2(gelu_tanh(bflo(tw[0])) * f0[0], gelu_tanh(bfhi(tw[0])) * f0[1]); o.y = pk2(gelu_tanh(bflo(tw[1])) * f0[2], gelu_tanh(bfhi(tw[1])) * f0[3]);
            o.z = pk2(gelu_tanh(bflo(tw[2])) * f1[0], gelu_tanh(bfhi(tw[2])) * f1[1]); o.w = pk2(gelu_tanh(bflo(tw[3])) * f1[2], gelu_tanh(bfhi(tw[3])) * f1[3]);
            *(u32x4*)(yp + q * 8) = o; }
    }
    __syncthreads();
}

__device__ __forceinline__ void unpack8(const u32x4 v, float (&f)[8]) { f[0] = bflo(v.x); f[1] = bfhi(v.x); f[2] = bflo(v.y); f[3] = bfhi(v.y); f[4] = bflo(v.z); f[5] = bfhi(v.z); f[6] = bflo(v.w); f[7] = bfhi(v.w); }
__device__ __forceinline__ void conv_phase(const KArgs& a, int l, int gt, int ngt, bool dry) {
    bf16_t* A = (bf16_t*)(wsp(a) + WS_A); bf16_t* HBd = (bf16_t*)(wsp(a) + WS_HB); const bf16_t* HL = (const bf16_t*)(wsp(a) + WS_HALO);
    const float* cw = ain(a, 22) + (size_t)l * 3 * F2; const float* cb = ain(a, 23) + (size_t)l * F2;
    constexpr int NCC = FH / 8, NRG = M / 32;
    for (int it = gt; it < NRG * NCC; it += ngt) {
        const int rg = it / NCC, c = (it % NCC) * 8;
        const int rs = rg * 32, p0 = rs % TB;
        if (l == 1 && p0 < CTX) continue;
        const bool seg_start = (p0 == 0) || (p0 == CTX), seg_end = (p0 + 31 == CTX - 1) || (p0 + 31 == TB - 1);
        float w0g[8], w1g[8], w2g[8], bg[8], w0v[8], w1v[8], w2v[8], bv[8];
#define LD8(dst, src) do { const f32x4 t0_ = *(const f32x4*)(src), t1_ = *(const f32x4*)((src) + 4); dst[0] = t0_[0]; dst[1] = t0_[1]; dst[2] = t0_[2]; dst[3] = t0_[3]; dst[4] = t1_[0]; dst[5] = t1_[1]; dst[6] = t1_[2]; dst[7] = t1_[3]; } while (0)
        LD8(w0g, cw + c); LD8(w1g, cw + F2 + c); LD8(w2g, cw + 2 * F2 + c); LD8(bg, cb + c);
        LD8(w0v, cw + FH + c); LD8(w1v, cw + F2 + FH + c); LD8(w2v, cw + 2 * F2 + FH + c); LD8(bv, cb + FH + c);
#undef LD8
        u32x4 pgw = (u32x4){0u, 0u, 0u, 0u}, pvw = pgw, cgw, cvw;
        if (!seg_start) { const bf16_t* hp = HL + (size_t)((rg - 1) * 2 + 1) * F2 + c; pgw = *(const u32x4*)hp; pvw = *(const u32x4*)(hp + FH); }
        { const bf16_t* cp = A + (size_t)rs * F2 + c; cgw = *(const u32x4*)cp; cvw = *(const u32x4*)(cp + FH); }
        for (int t0 = 0; t0 < 32; t0 += 4) {
            u32x4 ngw[4], nvw[4];
#pragma unroll
            for (int q = 0; q < 4; ++q) {
                const int t = t0 + q + 1;
                if (t < 32) { const bf16_t* np = A + (size_t)(rs + t) * F2 + c; ngw[q] = *(const u32x4*)np; nvw[q] = *(const u32x4*)(np + FH); }
                else if (seg_end) { ngw[q] = (u32x4){0u, 0u, 0u, 0u}; nvw[q] = ngw[q]; }
                else { const bf16_t* hp = HL + (size_t)((rg + 1) * 2) * F2 + c; ngw[q] = *(const u32x4*)hp; nvw[q] = *(const u32x4*)(hp + FH); }
            }
#pragma unroll
            for (int q = 0; q < 4; ++q) {
                float pg[8], pv[8], cg_[8], cv[8], ng[8], nv[8];
                unpack8(pgw, pg); unpack8(pvw, pv); unpack8(cgw, cg_); unpack8(cvw, cv); unpack8(ngw[q], ng); unpack8(nvw[q], nv);
                float o[8];
#pragma unroll
                for (int e = 0; e < 8; ++e) { const float gg = bg[e] + w0g[e] * pg[e] + w1g[e] * cg_[e] + w2g[e] * ng[e]; const float vv = bv[e] + w0v[e] * pv[e] + w1v[e] * cv[e] + w2v[e] * nv[e];
                    o[e] = siluf_(gg) * vv; }
                u32x4 ow; ow.x = pk2(o[0], o[1]); ow.y = pk2(o[2], o[3]); ow.z = pk2(o[4], o[5]); ow.w = pk2(o[6], o[7]);
                if (dry) *(u32x4*)(HBd + ((size_t)(rs + t0 + q) * F2 + c) % ((size_t)33 * 1024 * 1024 - 8)) = ow; else *(u32x4*)(A + (size_t)(rs + t0 + q) * F2 + c) = ow;
                pgw = cgw; pvw = cvw; cgw = ngw[q]; cvw = nvw[q];
            }
        }
    }
}

__device__ __forceinline__ void final_norm(const KArgs& a, int gw, int ngw, int lane) {
    const float* g = ain(a, 25);
    for (int r = gw; r < NB * SEQ; r += ngw) {
        float* row = outp(a) + (size_t)r * D;
        f32x4 v[4]; float ss = 0.f;
#pragma unroll
        for (int j = 0; j < 4; ++j) { v[j] = *(const f32x4*)(row + (lane + 64 * j) * 4); ss += (v[j][0] * v[j][0] + v[j][1] * v[j][1]) + (v[j][2] * v[j][2] + v[j][3] * v[j][3]); }
        const float rstd = __builtin_amdgcn_rsqf(wave_sum(ss) * (1.0f / D) + EPS);
#pragma unroll
        for (int j = 0; j < 4; ++j) { const f32x4 gv = *(const f32x4*)(g + (lane + 64 * j) * 4); *(f32x4*)(row + (lane + 64 * j) * 4) = v[j] * rstd * gv; }
    }
}

#define LAS __attribute__((address_space(3)))
#define XB_TMO      128
#define XB_XCNT(j)  (256  + 64 * (j))
#define XB_XSUB(j)  (1280 + 64 * (j))
#define XB_XGEN(j)  (2304 + 64 * (j))
#define XB_TOP      3328
#define XB_TOPGEN   3392
#define XCD_BAR_WORDS 3456
#define XB_SPIN_CAP (1u << 18)

__device__ __forceinline__ unsigned xb_ld(unsigned* p)              { return __hip_atomic_load(p, __ATOMIC_RELAXED, __HIP_MEMORY_SCOPE_AGENT); }
__device__ __forceinline__ unsigned xb_add(unsigned* p, unsigned v) { return __hip_atomic_fetch_add(p, v, __ATOMIC_RELAXED, __HIP_MEMORY_SCOPE_AGENT); }
__device__ __forceinline__ unsigned xb_xcc_id() { return (unsigned)__builtin_amdgcn_s_getreg((3 << 11) | 20) & 0xFu; }
#define XB_SPIN(cond, bar) do { unsigned _sp = 0; while (cond) { __builtin_amdgcn_s_sleep(1); \
    if ((++_sp & 255u) == 0u) { if (xb_ld(&(bar)[XB_TMO])) break; if (_sp > XB_SPIN_CAP) { atomicAdd(&(bar)[XB_TMO], 1u); break; } } } } while (0)

struct XcdBarrier {
    unsigned* bar; unsigned x;
    volatile LAS unsigned* st;
};

__device__ __forceinline__ XcdBarrier xcd_barrier_post(unsigned* bar, volatile LAS unsigned* st) {
    XcdBarrier b; b.bar = bar; b.x = xb_xcc_id(); b.st = st;
    if (threadIdx.x == 0) (void)xb_add(&bar[XB_XCNT(b.x)], 1u);
    return b;
}
__device__ __forceinline__ void xcd_barrier_complete(unsigned* bar, unsigned x, unsigned& nloc, unsigned& nx) {
    const unsigned G = gridDim.x * gridDim.y * gridDim.z;
    unsigned sum, cnt, mine, sp = 0u;
    for (;;) {
        sum = 0u; cnt = 0u; mine = 0u;
#pragma unroll
        for (unsigned j = 0; j < 16; ++j) { const unsigned c = xb_ld(&bar[XB_XCNT(j)]); sum += c; cnt += (c > 0u) ? 1u : 0u; mine = (j == x) ? c : mine; }
        if (sum == G) break;
        __builtin_amdgcn_s_sleep(1);
        if ((++sp & 255u) == 0u) { if (xb_ld(&bar[XB_TMO])) break; if (sp > XB_SPIN_CAP) { atomicAdd(&bar[XB_TMO], 1u); break; } }
    }
    nloc = mine > 0u ? mine : 1u; nx = cnt > 0u ? cnt : 1u;
}

__device__ __forceinline__ void xcd_barrier(const XcdBarrier& b) {
    asm volatile("s_waitcnt vmcnt(0)" ::: "memory");
    __syncthreads();
    if (threadIdx.x == 0) {
        unsigned* bar = b.bar;
        __builtin_amdgcn_s_waitcnt(0);
        unsigned nloc = b.st[0], nx = b.st[1];
        if (nloc == 0u) { xcd_barrier_complete(bar, b.x, nloc, nx); b.st[0] = nloc; b.st[1] = nx; }
        const unsigned old = xb_add(&bar[XB_XSUB(b.x)], 1u);
        const unsigned gen = old / nloc;
        if (old + 1u == (gen + 1u) * nloc) {
            __builtin_amdgcn_fence(__ATOMIC_RELEASE, "agent");
            asm volatile("s_waitcnt vmcnt(0)" ::: "memory");
            const unsigned og = xb_add(&bar[XB_TOP], 1u);
            const unsigned tg = og / nx;
            if (og + 1u == (tg + 1u) * nx) xb_add(&bar[XB_TOPGEN], 1u);
            else XB_SPIN(xb_ld(&bar[XB_TOPGEN]) == tg, bar);
            __builtin_amdgcn_fence(__ATOMIC_ACQUIRE, "agent");
            xb_add(&bar[XB_XGEN(b.x)], 1u);
            asm volatile("s_waitcnt vmcnt(0)" ::: "memory");
        } else {
            XB_SPIN(xb_ld(&bar[XB_XGEN(b.x)]) == gen, bar);
            __builtin_amdgcn_fence(__ATOMIC_ACQUIRE, "agent");
            asm volatile("s_waitcnt vmcnt(0)" ::: "memory");
        }
    }
    __syncthreads();
}

#ifndef PHASEMASK
#define PHASEMASK 0xffffffffu
#endif
#define PH(k) (((PHASEMASK) >> (k)) & 1u)
#ifndef REPMASK
#define REPMASK 0u
#endif
#define NREP(k) ((((REPMASK) >> (k)) & 1u) ? 2 : 1)
__device__ __forceinline__ int q_next(unsigned* ctr, volatile int* slot) { __syncthreads(); if (threadIdx.x == 0) *slot = (int)atomicAdd(ctr, 1u); __syncthreads(); return __builtin_amdgcn_readfirstlane(*slot); }

__global__ void __launch_bounds__(NTHR, 2) fwd_megakernel(KArgs a) {
    extern __shared__ __attribute__((aligned(16))) unsigned char lds[];
    cg::grid_group grid = cg::this_grid();
    const int G = gridDim.x, ngw = G * NWV;
#define TLW() const int tid = opaque((int)threadIdx.x), lane = tid & 63, wave = __builtin_amdgcn_readfirstlane(tid >> 6), gw = blockIdx.x * NWV + wave; (void)lane; (void)gw
    unsigned* ctl = (unsigned*)(wsp(a) + WS_CTL);
    volatile int* slot = (volatile int*)(lds + LDS_SLOT);
    LASP unsigned char* lds3 = (LASP unsigned char*)lds;
    typedef pg8::StaticOrder SO; typedef pg8::RowOrder RO;
    { volatile LAS unsigned* st0 = (volatile LAS unsigned*)(lds3 + LDS_SLOT + 16); if (threadIdx.x < 2) st0[threadIdx.x] = 0u; }
    __syncthreads();
    const XcdBarrier xbar = xcd_barrier_post(ctl + 4096, (volatile LAS unsigned*)(lds3 + LDS_SLOT + 16));

    if constexpr (PH(0)) { TLW(); convert_weights(a, 0, (char*)lds, gw, ngw, wave, lane);
    __syncthreads();
    mods_phase(a, (char*)lds, tid); }
    if (a.ws == nullptr) grid.sync();
    xcd_barrier(xbar);

    for (int l = 0; l < 2; ++l) {
        const XPtrs X = xptrs(a, l);
        const float* MODl = (const float*)(wsp(a) + WS_MOD) + (size_t)l * 5 * 6144;
        if constexpr (PH(1)) for (int rp = 0; rp < NREP(8); ++rp) { TLW(); norm_phase(a, l, 1, X.in_lat, X.in_ctx, gw, ngw, lane); }
        if (PH(0) && l == 1) { TLW(); __syncthreads(); convert_weights(a, 1, (char*)lds, gw, ngw, wave, lane); }
        xcd_barrier(xbar);
        if constexpr (PH(2)) for (int rp = 0; rp < NREP(0); ++rp) { pg8::Gemm g{(const bf16_t*)(wsp(a) + WS_HB), (const bf16_t*)(wsp(a) + W_MIX), M, PMW, D, D}; RO S; S.init(PMW, G, (int)blockIdx.x, 0);
          pg8::EpiStore<0, false> E{(bf16_t*)(wsp(a) + WS_PM), PMW, nullptr};
          pg8::gemm_phase<pg8::EpiStore<0, false>, RO, true, true>(lds3, g, S, E); }
        xcd_barrier(xbar);
        if constexpr (PH(3)) { TLW(); if (NREP(12) > 1) qk_phase(a, l, gw, ngw, lane, true); qk_phase(a, l, gw, ngw, lane, false); }
        __syncthreads();
        if constexpr (PH(4)) { TLW(); unsigned* ctrA = ctl + 64 * (3 + l);
            for (;;) { int u = q_next(ctrA, slot); if (u >= GLA_UNITS_A * NREP(1)) break; u %= GLA_UNITS_A;
                const int sc = 16 - (u / 32), bhd = u % 32;
                if (((bhd & 1) == 0 && sc == 16) || ((bhd & 1) == 1 && sc == 1)) continue;
                gla_unit_a(a, l, bhd * GLA_NSC + sc, (char*)lds, tid, lane, wave); } }
        xcd_barrier(xbar);
        {
            unsigned* ctr = ctl + 64 * (1 + l);
            const attn_body::bf16* PMa = (const attn_body::bf16*)(wsp(a) + WS_PM); attn_body::bf16* Ya = (attn_body::bf16*)(wsp(a) + WS_Y);
            for (;;) {
                int u = q_next(ctr, slot);
                if (u < NB * 4 * GLA_NSC * NREP(3)) { u %= NB * 4 * GLA_NSC; const int sc = 16 - (u / 16), bh = u % 16; const int unit = bh * GLA_NSC + sc;
                    if (l == 1 && sc == 0) continue;
                    if constexpr (PH(6)) { TLW(); gla_unit_c(a, l, unit, (char*)lds, tid, lane, wave); } continue; }
                u -= NB * 4 * GLA_NSC * NREP(3);
                if (u < 1024 * NREP(2)) { u &= 1023; if constexpr (PH(5)) { const int b = u >> 8, hk = (u >> 7) & 1, qb = (u & 127) >> 2, h = hk * 4 + (u & 3);
                    const size_t qrow = (size_t)b * TB + CTX + (size_t)qb * 256;
                    attn_body::attn_unit<8>(PMa + qrow * PMW + C_Q + h * 64, PMa + (size_t)b * TB * PMW + C_K + hk * 64, PMa + (size_t)b * TB * PMW + C_VV + hk * 64, Ya + qrow * YW + 512 + h * 64, 132, (char*)lds); }
                    continue; }
                u -= 1024 * NREP(2);
                if (u < 32) { if (l == 1) continue; if constexpr (PH(5)) { const int b = u >> 3, h = u & 7, hk = h >> 2; const size_t qrow = (size_t)b * TB;
                    attn_body::attn_unit<8>(PMa + qrow * PMW + C_Q + h * 64, PMa + qrow * PMW + C_K + hk * 64, PMa + qrow * PMW + C_VV + hk * 64, Ya + qrow * YW + 512 + h * 64, 4, (char*)lds); }
                    continue; }
                u -= 32;
                if (u < NB * 66 * 4 * NREP(4)) { u %= NB * 66 * 4; if (l == 1 && ((u >> 2) % 66) < 2) continue; if constexpr (PH(7)) { TLW(); gmlp_unit(a, l, u, (char*)lds, tid, lane, wave); } continue; }
                break;
            }
        }
        xcd_barrier(xbar);
        if constexpr (PH(8)) for (int rp = 0; rp < NREP(5); ++rp) { pg8::Gemm g{(const bf16_t*)(wsp(a) + WS_HB), (const bf16_t*)(wsp(a) + W_GATE), M, NGATE, D, D}; RO S; S.init(NGATE, G, (int)blockIdx.x, l);
          pg8::EpiStore<2, false> E{(bf16_t*)(wsp(a) + WS_G), NGATE, nullptr};
          pg8::gemm_phase<pg8::EpiStore<2, false>, RO, true, true>(lds3, g, S, E); }
        xcd_barrier(xbar);
        if constexpr (PH(9)) for (int bq = 0; bq < 3 * NREP(6); ++bq) { const int bi = bq % 3;
            pg8::Gemm g{(const bf16_t*)(wsp(a) + WS_Y) + bi * 512, (const bf16_t*)(wsp(a) + W_BR) + (size_t)bi * D * 512, M, D, 512, YW}; RO S; S.init(D, G, (int)blockIdx.x, l);
            pg8::EpiBranch E{(bf16_t*)(wsp(a) + WS_HB), (const bf16_t*)(wsp(a) + WS_G) + bi * D, bi == 0 ? 1 : 0};
            pg8::gemm_phase<pg8::EpiBranch, RO, true, true>(lds3, g, S, E);
        }
        xcd_barrier(xbar);
        if constexpr (PH(10)) { pg8::Gemm g{(const bf16_t*)(wsp(a) + WS_HB), (const bf16_t*)(wsp(a) + W_OUT), M, D, D, D}; RO S; S.init(D, G, (int)blockIdx.x, l);
          pg8::EpiResid E{X, MODl, 2, nullptr};
          pg8::gemm_phase<pg8::EpiResid, RO, true, true>(lds3, g, S, E);
          if (NREP(10) > 1) { XPtrs X2 = X; X2.in_lat = X.out_lat; X2.in_ctx = X.out_ctx; pg8::EpiResid E2{X2, MODl, 2, (const float*)(wsp(a) + 32768)}; pg8::gemm_phase<pg8::EpiResid, RO, true, true>(lds3, g, S, E2); } }
        xcd_barrier(xbar);
        if constexpr (PH(1)) for (int rp = 0; rp < NREP(8); ++rp) { TLW(); norm_phase(a, l, 2, X.out_lat, X.out_ctx, gw, ngw, lane); }
        xcd_barrier(xbar);
        if constexpr (PH(11)) for (int rp = 0; rp < NREP(7); ++rp) { pg8::Gemm g{(const bf16_t*)(wsp(a) + WS_HB), (const bf16_t*)(wsp(a) + W_UP), M, F2, D, D}; RO S; S.init(F2, G, (int)blockIdx.x, l);
          pg8::EpiStore<0, true> E{(bf16_t*)(wsp(a) + WS_A), F2, (bf16_t*)(wsp(a) + WS_HALO)};
          pg8::gemm_phase<pg8::EpiStore<0, true>, RO, true, true>(lds3, g, S, E); }
        xcd_barrier(xbar);
        if constexpr (PH(12)) { TLW(); if (NREP(11) > 1) { conv_phase(a, l, blockIdx.x * NTHR + tid, G * NTHR, true); __syncthreads(); } conv_phase(a, l, blockIdx.x * NTHR + tid, G * NTHR, false); }
        xcd_barrier(xbar);
        if constexpr (PH(13)) { pg8::Gemm g{(const bf16_t*)(wsp(a) + WS_A), (const bf16_t*)(wsp(a) + W_DOWN), M, D, FH, F2}; RO S; S.init(D, G, (int)blockIdx.x, l);
          XPtrs X2 = X; X2.in_lat = X.out_lat; X2.in_ctx = X.out_ctx;
          pg8::EpiResid E{X2, MODl, 5, nullptr};
          pg8::gemm_phase<pg8::EpiResid, RO, true, true>(lds3, g, S, E);
          if (NREP(10) > 1) { pg8::EpiResid E2{X2, MODl, 5, (const float*)(wsp(a) + 32768)}; pg8::gemm_phase<pg8::EpiResid, RO, true, true>(lds3, g, S, E2); } }
        xcd_barrier(xbar);
    }
#ifdef XSYNC
    for (int q = 0; q < XSYNC; ++q) xcd_barrier(xbar);
#endif
    { TLW(); final_norm(a, gw, ngw, lane); }
}

extern "C" void kernel_launch(void* const* d_in, const int* in_sizes, int n_in, void* d_out, int out_size, void* d_ws, size_t ws_size, hipStream_t stream) {
    static int grid_blocks = 0;
    if (grid_blocks == 0) {
        if (n_in != 26 || ws_size < WS_END) { fprintf(stderr, "kernel_launch: unexpected n_in %d / ws_size %zu\n", n_in, ws_size); grid_blocks = -1; return; }
        int dev = 0, cus = 0, per_cu = 0;
        hipGetDevice(&dev); hipDeviceGetAttribute(&cus, hipDeviceAttributeMultiprocessorCount, dev);
        if (hipFuncSetAttribute((const void*)fwd_megakernel, hipFuncAttributeMaxDynamicSharedMemorySize, LDS_BYTES) != hipSuccess) { fprintf(stderr, "kernel_launch: hipFuncSetAttribute failed\n"); }
        if (hipOccupancyMaxActiveBlocksPerMultiprocessor(&per_cu, (const void*)fwd_megakernel, NTHR, LDS_BYTES) != hipSuccess || per_cu < 1) { fprintf(stderr, "kernel_launch: occupancy query says %d\n", per_cu); per_cu = 1; }
        (void)hipGetLastError();
        grid_blocks = cus * 1;
    }
    if (grid_blocks < 0) return;
    hipMemsetAsync((char*)d_ws + WS_CTL, 0, 65536, stream);
    KArgs a{};
    for (int i = 0; i < 26; ++i) a.in[i] = (const float*)d_in[i];
    a.out = (float*)d_out; a.ws = (unsigned char*)d_ws;
    void* args[] = {&a};
    hipError_t e = hipLaunchCooperativeKernel((const void*)fwd_megakernel, dim3(grid_blocks), dim3(NTHR), args, LDS_BYTES, stream);
    if (e != hipSuccess) fprintf(stderr, "cooperative launch failed: %s (grid %d)\n", hipGetErrorString(e), grid_blocks);
}
```
